# Optimizing an MI355X kernel written in HIP

```python
import math
import jax, jax.numpy as jnp
from jax import lax
import numpy as np

D_MODEL = 1024
BATCH = 2
SEQ = 8192
DEPTH = 4
DEC_BATCH = 16
DEC_SEQ = 2048
PAST_LEN = 128

HEAD_DIM = 64
A_PATTERNS = ((128, 1), (512, 4), (2048, 16))
A_GROUPS = 3
A_HEADS = 8
A_WIDTH = A_HEADS * HEAD_DIM
B_HEADS = 8
B_KV_HEADS = 2
B_HALF = 128
B_WIDTH = B_HEADS * HEAD_DIM
C_HEADS = 4
C_VDIM = 2 * HEAD_DIM
C_WIDTH = C_HEADS * C_VDIM
N_BRANCH = 3
Q_BLOCK = 128
RMS_EPS = 1e-6
NEG_INF = -1e30
IN_SIZES = (
    A_GROUPS * A_WIDTH, A_GROUPS * A_WIDTH, A_GROUPS * A_WIDTH, A_WIDTH,
    B_WIDTH, B_KV_HEADS * HEAD_DIM, B_KV_HEADS * HEAD_DIM, B_WIDTH,
    2 * C_HEADS * HEAD_DIM, 2 * C_HEADS * HEAD_DIM, C_WIDTH, C_WIDTH,
    N_BRANCH * D_MODEL,
)
D_IN = sum(IN_SIZES)

kernel_name = 'hybrid_dilated_window_diff_encoder'


def rmsnorm(x, g):
    xf = x.astype(jnp.float32)
    y = xf * lax.rsqrt(jnp.mean(xf * xf, axis=-1, keepdims=True) + RMS_EPS)
    return (y * g.astype(jnp.float32)).astype(x.dtype)


def alibi_slopes(n):
    return jnp.asarray([2.0 ** (-8.0 * (i + 1) / n) for i in range(n)], dtype=jnp.float32)


def banded_attention(q, k, v, half, slopes, dist_scale, sink=None):
    n, s_len, h, d = q.shape
    hkv = k.shape[2]
    grp = h // hkv
    blk = half
    nb = -(-s_len // blk)
    pad = nb * blk - s_len
    f32 = jnp.float32
    qp = jnp.pad(q.astype(f32), ((0, 0), (0, pad), (0, 0), (0, 0)))
    kv_pad = ((0, 0), (blk, blk + pad), (0, 0), (0, 0))
    kb = jnp.pad(k.astype(f32), kv_pad).reshape(n, nb + 2, blk, hkv, k.shape[-1])
    vb = jnp.pad(v.astype(f32), kv_pad).reshape(n, nb + 2, blk, hkv, v.shape[-1])
    kw = jnp.concatenate([kb[:, :-2], kb[:, 1:-1], kb[:, 2:]], axis=2)
    vw = jnp.concatenate([vb[:, :-2], vb[:, 1:-1], vb[:, 2:]], axis=2)
    qb = qp.reshape(n, nb, blk, hkv, grp, d)
    s = jnp.einsum('nbqhgd,nbkhd->nbhgqk', qb, kw) * (d ** -0.5)
    koff = jnp.arange(3 * blk) - blk
    rel = koff[None, :] - jnp.arange(blk)[:, None]
    kpos = jnp.arange(nb)[:, None] * blk + koff[None, :]
    mask = (jnp.abs(rel) <= half)[None] & ((kpos >= 0) & (kpos < s_len))[:, None, :]
    bias = -slopes.astype(f32).reshape(hkv, grp, 1, 1) * (jnp.abs(rel).astype(f32) * dist_scale)
    s = jnp.where(mask[None, :, None, None], s + bias, NEG_INF)
    m = jnp.max(s, axis=-1)
    if sink is not None:
        sk = sink.astype(f32).reshape(1, 1, hkv, grp, 1)
        m = jnp.maximum(m, sk)
    e = jnp.exp(s - m[..., None])
    l = jnp.sum(e, axis=-1)
    if sink is not None:
        l = l + jnp.exp(sk - m)
    o = jnp.einsum('nbhgqk,nbkhd->nbqhgd', e, vw) / jnp.moveaxis(l, -1, 2)[..., None]
    o = o.reshape(n, nb * blk, h, v.shape[-1])[:, :s_len]
    lse = jnp.moveaxis(m + jnp.log(l), -1, 2).reshape(n, nb * blk, h)[:, :s_len]
    return o, lse


def dilated_attention(q, k, v):
    b, s_len = q.shape[:2]
    slopes_all = alibi_slopes(A_GROUPS * A_HEADS).reshape(A_GROUPS, A_HEADS)
    outs, lses = [], []
    for gi, (window, dil) in enumerate(A_PATTERNS):
        half = window // (2 * dil)
        sub = s_len // dil

        def to_sub(t):
            t = t[:, :, gi].reshape(b, sub, dil, A_HEADS, t.shape[-1])
            return jnp.swapaxes(t, 1, 2).reshape(b * dil, sub, A_HEADS, t.shape[-1])

        o, lse = banded_attention(to_sub(q), to_sub(k), to_sub(v), half, slopes_all[gi], float(dil))
        o = jnp.swapaxes(o.reshape(b, dil, sub, A_HEADS, HEAD_DIM), 1, 2).reshape(b, s_len, A_HEADS, HEAD_DIM)
        lse = jnp.swapaxes(lse.reshape(b, dil, sub, A_HEADS), 1, 2).reshape(b, s_len, A_HEADS)
        outs.append(o)
        lses.append(lse)
    w = jax.nn.softmax(jnp.stack(lses, 0), axis=0)
    return jnp.einsum('gbsh,gbshd->bshd', w, jnp.stack(outs, 0))


def differential_attention(q, k, v, lam, lam_init, subln_g):
    f32 = jnp.float32
    b, s_len = q.shape[:2]
    nb = s_len // Q_BLOCK
    slopes = alibi_slopes(C_HEADS)
    kpos = jnp.arange(s_len)
    kf = k.astype(f32)
    vf = v.astype(f32)
    qb = jnp.moveaxis(q.astype(f32).reshape(b, nb, Q_BLOCK, C_HEADS, 2, HEAD_DIM), 1, 0)

    def one_block(args):
        qblk, i = args
        qpos = i * Q_BLOCK + jnp.arange(Q_BLOCK)
        bias = -slopes[:, None, None] * jnp.abs(qpos[:, None] - kpos[None, :]).astype(f32)
        s = jnp.einsum('bqhcd,bkhcd->bchqk', qblk, kf) * (HEAD_DIM ** -0.5) + bias
        p = jax.nn.softmax(s, axis=-1)
        a = p[:, 0] - lam * p[:, 1]
        return jnp.einsum('bhqk,bkhd->bqhd', a, vf)

    o = lax.map(one_block, (qb, jnp.arange(nb)))
    o = jnp.moveaxis(o, 0, 1).reshape(b, s_len, C_HEADS, C_VDIM)
    return rmsnorm(o, subln_g) * (1.0 - lam_init)


def hybrid_layer(x, layer_idx, norm_g, w_in, w_oa, w_ob, w_oc, w_out, b_sink,
                 lam_q1, lam_k1, lam_q2, lam_k2, c_subln_g):
    b, s_len, _ = x.shape
    h = rmsnorm(x, norm_g)
    proj = h @ w_in
    splits = [int(c) for c in np.cumsum(IN_SIZES)[:-1]]
    qa, ka, va, ga, qb, kb, vb, gb, qc, kc, vc, gc, gm = jnp.split(proj, splits, axis=-1)
    a5 = lambda t: t.reshape(b, s_len, A_GROUPS, A_HEADS, HEAD_DIM)
    oa = dilated_attention(a5(qa), a5(ka), a5(va)).reshape(b, s_len, A_WIDTH).astype(x.dtype)
    ya = (oa * jax.nn.silu(ga)) @ w_oa
    ob, _ = banded_attention(qb.reshape(b, s_len, B_HEADS, HEAD_DIM),
                             kb.reshape(b, s_len, B_KV_HEADS, HEAD_DIM),
                             vb.reshape(b, s_len, B_KV_HEADS, HEAD_DIM),
                             B_HALF, alibi_slopes(B_HEADS), 1.0, sink=b_sink)
    ob = ob.reshape(b, s_len, B_WIDTH).astype(x.dtype)
    yb = (ob * jax.nn.silu(gb)) @ w_ob
    lam_init = 0.8 - 0.6 * math.exp(-0.3 * layer_idx)
    f32 = jnp.float32
    lam = (jnp.exp(jnp.sum(lam_q1.astype(f32) * lam_k1.astype(f32)))
           - jnp.exp(jnp.sum(lam_q2.astype(f32) * lam_k2.astype(f32))) + lam_init)
    oc = differential_attention(qc.reshape(b, s_len, C_HEADS, 2, HEAD_DIM),
                                kc.reshape(b, s_len, C_HEADS, 2, HEAD_DIM),
                                vc.reshape(b, s_len, C_HEADS, C_VDIM), lam, lam_init, c_subln_g)
    oc = oc.reshape(b, s_len, C_WIDTH).astype(x.dtype)
    yc = (oc * jax.nn.silu(gc)) @ w_oc
    gates = jax.nn.sigmoid(gm.reshape(b, s_len, N_BRANCH, D_MODEL))
    mixed = gates[:, :, 0] * ya + gates[:, :, 1] * yb + gates[:, :, 2] * yc
    return x + mixed @ w_out


def setup_inputs(seed: int = 0) -> dict:
    key = jax.random.key(seed)
    ks = jax.random.split(key, 16)
    f32 = jnp.float32

    def nrm(k, shape, scale):
        return jax.random.normal(k, shape, f32) * scale

    return {
        'x_prompt': nrm(ks[0], (BATCH, SEQ, D_MODEL), 1.0),
        'x_sample': nrm(ks[1], (DEC_BATCH, DEC_SEQ, D_MODEL), 1.0),
        'norm_g': 1.0 + nrm(ks[2], (DEPTH, D_MODEL), 0.02),
        'w_in': nrm(ks[3], (DEPTH, D_MODEL, D_IN), D_MODEL ** -0.5),
        'w_oa': nrm(ks[4], (DEPTH, A_WIDTH, D_MODEL), A_WIDTH ** -0.5),
        'w_ob': nrm(ks[5], (DEPTH, B_WIDTH, D_MODEL), B_WIDTH ** -0.5),
        'w_oc': nrm(ks[6], (DEPTH, C_WIDTH, D_MODEL), C_WIDTH ** -0.5),
        'w_out': nrm(ks[7], (DEPTH, D_MODEL, D_MODEL), D_MODEL ** -0.5),
        'b_sink': nrm(ks[8], (DEPTH, B_HEADS), 0.5),
        'lam_q1': nrm(ks[9], (DEPTH, HEAD_DIM), 0.1),
        'lam_k1': nrm(ks[10], (DEPTH, HEAD_DIM), 0.1),
        'lam_q2': nrm(ks[11], (DEPTH, HEAD_DIM), 0.1),
        'lam_k2': nrm(ks[12], (DEPTH, HEAD_DIM), 0.1),
        'c_subln_g': 1.0 + nrm(ks[13], (DEPTH, C_VDIM), 0.02),
        'final_norm_g': 1.0 + nrm(ks[14], (D_MODEL,), 0.02),
    }


def reference(x_prompt, x_sample, norm_g, w_in, w_oa, w_ob, w_oc, w_out, b_sink,
              lam_q1, lam_k1, lam_q2, lam_k2, c_subln_g, final_norm_g):
    def trunk(x):
        for l in range(DEPTH):
            x = hybrid_layer(x, l, norm_g[l], w_in[l], w_oa[l], w_ob[l], w_oc[l], w_out[l], b_sink[l],
                             lam_q1[l], lam_k1[l], lam_q2[l], lam_k2[l], c_subln_g[l])
        return rmsnorm(x, final_norm_g)

    y_prompt = trunk(x_prompt)
    y_sample = trunk(x_sample)
    return (y_prompt, y_sample)
```

```cpp
#include <hip/hip_runtime.h>
#include <hip/hip_cooperative_groups.h>
#include <cstdio>
#include <cstdint>
namespace cg = cooperative_groups;

constexpr int DM = 1024, DIN = 11520, NTOK = 49152, MC = 16384, NCHUNK = 3, DEPTH = 4;
constexpr int QA = 0, KA = 1536, VA = 3072, GA = 4608, QB = 5120, KB = 5632, VB = 5760, GB = 5888, QC = 6400, KC = 6912, VC = 7424, GC = 7936, GM = 8448;
constexpr float RMS_EPS = 1e-6f, LOG2E = 1.4426950408889634f, QSCALE = 0.125f * 1.4426950408889634f;
constexpr size_t MiB = 1u << 20;
constexpr size_t WS_ROWSS = 0;
constexpr size_t WS_BAR = 512 * 1024;
constexpr int MISC_BASE = 139264, MISC_OFF = MISC_BASE + 320;
constexpr size_t WS_WIN = 1 * MiB;
constexpr size_t WS_WO3 = 91 * MiB;
constexpr size_t WS_WOUT = 103 * MiB;
constexpr size_t WS_XB = 111 * MiB;
constexpr size_t WS_P = 207 * MiB;
constexpr size_t WS_ACT = 567 * MiB;
constexpr size_t WS_MIX = 615 * MiB;
constexpr size_t WS_END = 647 * MiB;
constexpr int LDS_BYTES = 147456;
#define PB(col) ((size_t)((col) >> 6) * MC * 64 + ((col) & 63))

namespace pg8 {
#define PG8_LAS __attribute__((address_space(3)))
typedef unsigned short bf16_t;
typedef short bf16x8 __attribute__((ext_vector_type(8)));
typedef float f32x4 __attribute__((ext_vector_type(4)));
typedef unsigned u32x4 __attribute__((ext_vector_type(4)));
constexpr int BM = 256, BK = 64, HALF = 128, HTB = HALF * BK * 2  , STAGE_BYTES = 8 * HTB, NXCD = 8, WGM = 4;

__host__ __device__ __forceinline__ int lds_byte(int r, int c) { const int st = (r >> 4) * 2 + (c >> 5), rr = r & 15, cc = c & 31, ob = rr * 64 + cc * 2; return st * 1024 + (ob ^ (((ob >> 9) & 1) << 5)); }
__host__ __device__ __forceinline__ void stage_rc(int b, int& R, int& C) { const int st = b / 1024, sb = b % 1024, swz = sb ^ (((sb >> 9) & 1) << 5); R = (st >> 1) * 16 + swz / 64; C = (st & 1) * 32 + (swz % 64) / 2; }
__host__ __device__ __forceinline__ int perm32(int rho) { const int n = rho >> 4, i = rho & 15; return 8 * (i >> 2) + 4 * n + (i & 3); }

struct Unit { int pm, pn, br; };
struct Gemm { const bf16_t* A; const bf16_t* Bt; int M, N, K; size_t abr, bbr; };

struct OrderXcd {
    int nM, nN, nwg, G, c;
    __device__ void init(int M, int N, int G_, int c_) { nM = M / BM; nN = N / BM; nwg = nM * nN; G = G_; c = c_; }
    __device__ bool next(int i, Unit& u) const {
        const long L = (long)i * G + c; if (L >= nwg) return false;
        int wgid = (int)L; { const int q = nwg / NXCD, r = nwg % NXCD, xcd = wgid % NXCD, off = wgid / NXCD; wgid = (xcd < r ? xcd * (q + 1) : r * (q + 1) + (xcd - r) * q) + off; }
        const int nig = WGM * nN, gid = wgid / nig, fm = gid * WGM, gsz = (nM - fm) < WGM ? (nM - fm) : WGM;
        u.pm = fm + ((wgid % nig) % gsz); u.pn = (wgid % nig) / gsz; u.br = 0; return true;
    }
};
__device__ __forceinline__ void xcd_tile(int tl, int nN, int ntile, Unit& u) { if (nN == 4 && ntile == 256) { const int x = tl & 7, k = tl >> 3; u.pm = 8 * x + (k >> 2); u.pn = k & 3; } else { u.pm = tl / nN; u.pn = tl % nN; } }
struct OrderMix { int nN, ntile, G, c;
    __device__ bool next(int i, Unit& u) const { const int j = i / 3; const int tl = j * G + c; if (tl >= ntile) return false; xcd_tile(tl, nN, ntile, u); u.br = i - 3 * j; return true; } };
struct OrderFixed { int pm, pn; bool on;
    __device__ bool next(int i, Unit& u) const { if (i > 0 || !on) return false; u.pm = pm; u.pn = pn; u.br = 0; return true; } };
struct OrderOne { int nN, ntile, G, c;
    __device__ bool next(int i, Unit& u) const { const int tl = i * G + c; if (tl >= ntile) return false; xcd_tile(tl, nN, ntile, u); u.br = 0; return true; } };

__device__ __forceinline__ unsigned cvt_pk_bf16(float lo, float hi) { unsigned r; asm volatile("v_cvt_pk_bf16_f32 %0, %1, %2" : "=v"(r) : "v"(lo), "v"(hi)); return r; }
__device__ __forceinline__ float bf_lo(unsigned w) { return __uint_as_float(w << 16); }
__device__ __forceinline__ float bf_hi(unsigned w) { return __uint_as_float(w & 0xffff0000u); }
__device__ __forceinline__ float sigmoidf_(float x) { return __builtin_amdgcn_rcpf(1.0f + __builtin_amdgcn_exp2f(-x * 1.4426950408889634f)); }

struct EpiProj {
    static constexpr bool PERM = true;
    bf16_t* O; const float* rowss;
    __device__ __forceinline__ void operator()(const f32x4 (&acc)[2][2][4][2], const Unit& u, int wr, int wc, int fr, int fq) const {
        const int row0 = u.pm * BM + wr * 64 + fr, col0 = u.pn * BM + wc * 32 + 8 * fq, pn = u.pn;
        const float sc = (pn < 6 || (pn >= 20 && pn < 22) || (pn >= 25 && pn < 27)) ? 0.125f * 1.4426950408889634f : 1.0f;
        float rsv[2][4];
#pragma unroll
        for (int ai = 0; ai < 2; ++ai)
#pragma unroll
            for (int m = 0; m < 4; ++m) rsv[ai][m] = rowss[row0 + ai * HALF + m * 16];
#pragma unroll
        for (int ai = 0; ai < 2; ++ai)
#pragma unroll
            for (int m = 0; m < 4; ++m) { const int row = row0 + ai * HALF + m * 16; const float rs = rsqrtf(rsv[ai][m] * (1.0f / 1024.0f) + 1e-6f) * sc;
#pragma unroll
                for (int bj = 0; bj < 2; ++bj) { const f32x4 v0 = acc[ai][bj][m][0] * rs, v1 = acc[ai][bj][m][1] * rs;
                    u32x4 w; w.x = cvt_pk_bf16(v0[0], v0[1]); w.y = cvt_pk_bf16(v0[2], v0[3]); w.z = cvt_pk_bf16(v1[0], v1[1]); w.w = cvt_pk_bf16(v1[2], v1[3]);
                    *(u32x4*)(O + PB(col0 + bj * HALF) + (size_t)row * 64) = w; } }
    }
};
struct EpiMix {
    static constexpr bool PERM = true;
    const bf16_t* P; bf16_t* MIX;
    __device__ __forceinline__ void operator()(const f32x4 (&acc)[2][2][4][2], const Unit& u, int wr, int wc, int fr, int fq) const {
        const int row0 = u.pm * BM + wr * 64 + fr, col0 = u.pn * BM + wc * 32 + 8 * fq, br = u.br;
#pragma unroll
        for (int ai = 0; ai < 2; ++ai) {
            u32x4 gv[4][2], pv[4][2];
#pragma unroll
            for (int m = 0; m < 4; ++m)
#pragma unroll
                for (int bj = 0; bj < 2; ++bj) { const int row = row0 + ai * HALF + m * 16, col = col0 + bj * HALF;
                    gv[m][bj] = *(const u32x4*)(P + PB(8448 + br * 1024 + col) + (size_t)row * 64);
                    if (br > 0) pv[m][bj] = *(const u32x4*)(MIX + (size_t)row * 1024 + col); else pv[m][bj] = (u32x4){0u, 0u, 0u, 0u}; }
            asm volatile("" ::: "memory");
#pragma unroll
            for (int m = 0; m < 4; ++m) { const int row = row0 + ai * HALF + m * 16;
#pragma unroll
                for (int bj = 0; bj < 2; ++bj) { const int col = col0 + bj * HALF;
                    const u32x4 g = gv[m][bj];
                    bf16_t* mp = MIX + (size_t)row * 1024 + col;
                    f32x4 v0 = acc[ai][bj][m][0], v1 = acc[ai][bj][m][1];
                    v0[0] *= sigmoidf_(bf_lo(g.x)); v0[1] *= sigmoidf_(bf_hi(g.x)); v0[2] *= sigmoidf_(bf_lo(g.y)); v0[3] *= sigmoidf_(bf_hi(g.y));
                    v1[0] *= sigmoidf_(bf_lo(g.z)); v1[1] *= sigmoidf_(bf_hi(g.z)); v1[2] *= sigmoidf_(bf_lo(g.w)); v1[3] *= sigmoidf_(bf_hi(g.w));
                    if (br > 0) { const u32x4 p = pv[m][bj];
                        v0[0] += bf_lo(p.x); v0[1] += bf_hi(p.x); v0[2] += bf_lo(p.y); v0[3] += bf_hi(p.y); v1[0] += bf_lo(p.z); v1[1] += bf_hi(p.z); v1[2] += bf_lo(p.w); v1[3] += bf_hi(p.w); }
                    u32x4 w; w.x = cvt_pk_bf16(v0[0], v0[1]); w.y = cvt_pk_bf16(v0[2], v0[3]); w.z = cvt_pk_bf16(v1[0], v1[1]); w.w = cvt_pk_bf16(v1[2], v1[3]);
                    *(u32x4*)mp = w; } }
            asm volatile("" ::: "memory");
        }
    }
};
struct EpiOut {
    static constexpr bool PERM = true;
    const float* base; float* out; bf16_t* xb; float* rowss_next;
    __device__ __forceinline__ void operator()(const f32x4 (&acc)[2][2][4][2], const Unit& u, int wr, int wc, int fr, int fq) const {
        const int row0 = u.pm * BM + wr * 64 + fr, col0 = u.pn * BM + wc * 32 + 8 * fq;
#pragma unroll
        for (int ai = 0; ai < 2; ++ai)
#pragma unroll
            for (int mh = 0; mh < 2; ++mh) {
                f32x4 bv[2][2][2];
#pragma unroll
                for (int ml = 0; ml < 2; ++ml)
#pragma unroll
                    for (int bj = 0; bj < 2; ++bj) { const size_t off = (size_t)(row0 + ai * HALF + (2 * mh + ml) * 16) * 1024 + col0 + bj * HALF;
                        bv[ml][bj][0] = *(const f32x4*)(base + off); bv[ml][bj][1] = *(const f32x4*)(base + off + 4); }
                asm volatile("" ::: "memory");
#pragma unroll
                for (int ml = 0; ml < 2; ++ml) { const int m = 2 * mh + ml; const int row = row0 + ai * HALF + m * 16; float s = 0.f;
#pragma unroll
                    for (int bj = 0; bj < 2; ++bj) { const size_t off = (size_t)row * 1024 + col0 + bj * HALF;
                        const f32x4 v0 = bv[ml][bj][0] + acc[ai][bj][m][0], v1 = bv[ml][bj][1] + acc[ai][bj][m][1];
                        *(f32x4*)(out + off) = v0; *(f32x4*)(out + off + 4) = v1;
                        u32x4 w; w.x = cvt_pk_bf16(v0[0], v0[1]); w.y = cvt_pk_bf16(v0[2], v0[3]); w.z = cvt_pk_bf16(v1[0], v1[1]); w.w = cvt_pk_bf16(v1[2], v1[3]);
                        *(u32x4*)(xb + off) = w;
                        s += (v0[0] * v0[0] + v0[1] * v0[1]) + (v0[2] * v0[2] + v0[3] * v0[3]) + (v1[0] * v1[0] + v1[1] * v1[1]) + (v1[2] * v1[2] + v1[3] * v1[3]); }
                    s += __shfl_xor(s, 16); s += __shfl_xor(s, 32);
                    if (fq == 0) atomicAdd(rowss_next + row, s); }
                asm volatile("" ::: "memory");
            }
    }
};

template <class Epi, class Sched, bool ALIGN_EPI = false, bool SP2 = false>
__device__ __forceinline__ void gemm_phase(PG8_LAS unsigned char* lds, const Gemm g, const Sched& S, const Epi& E) {
    int tid = threadIdx.x; asm volatile("" : "+v"(tid));
    const int wid = __builtin_amdgcn_readfirstlane(tid >> 6), lane = tid & 63, wr = wid >> 2, wc = wid & 3, fr = lane & 15, fq = lane >> 4;
    const int K = g.K, nt = K / BK;
    unsigned voffA[2], voffB[2];
#pragma unroll
    for (int i = 0; i < 2; ++i) { int R, C; stage_rc(tid * 16 + i * 8192, R, C); const int Rb = Epi::PERM ? ((R & ~31) + perm32(R & 31)) : R;
        voffA[i] = (unsigned)(R * K + C) * 2u; voffB[i] = (unsigned)(Rb * K + C) * 2u; }
    const size_t kstep = (size_t)(BK * 2);
    const size_t hstep = (size_t)HALF * K * 2;
    const size_t tstep = 2 * hstep;
    const unsigned ldsw = (unsigned)wid * 1024u;
    const int aoff = lds_byte(wr * 64 + fr, fq * 8), boff = lds_byte(wc * 32 + fr, fq * 8);
#define PG8_SA(b, h) (((b) * 2 + (h)) * HTB)
#define PG8_SB(b, h) ((4 + (b) * 2 + (h)) * HTB)
#define PG8_STAGE(bufoff, gbase, voff) do { _Pragma("unroll") for (int _i = 0; _i < 2; ++_i) \
        __builtin_amdgcn_global_load_lds((const unsigned*)((const char*)(gbase) + (voff)[_i]), (PG8_LAS unsigned*)(lds + (bufoff) + ldsw + _i * 8192), 16, 0, 0); } while (0)
#define PG8_LDA(dst, b, h) do { _Pragma("unroll") for (int m = 0; m < 4; ++m) _Pragma("unroll") for (int k = 0; k < 2; ++k) dst[m][k] = *(const PG8_LAS bf16x8*)(lds + PG8_SA(b, h) + aoff + m * 2048 + k * 1024); } while (0)
#define PG8_LDB(dst, b, h) do { _Pragma("unroll") for (int n = 0; n < 2; ++n) _Pragma("unroll") for (int k = 0; k < 2; ++k) dst[n][k] = *(const PG8_LAS bf16x8*)(lds + PG8_SB(b, h) + boff + n * 2048 + k * 1024); } while (0)
#define PG8_MMA(ai, bj, At, Bt) do { __builtin_amdgcn_s_setprio(1); _Pragma("unroll") for (int m = 0; m < 4; ++m) _Pragma("unroll") for (int n = 0; n < 2; ++n) _Pragma("unroll") for (int k = 0; k < 2; ++k) \
        acc[ai][bj][m][n] = __builtin_amdgcn_mfma_f32_16x16x32_bf16(Bt[n][k], At[m][k], acc[ai][bj][m][n], 0, 0, 0); __builtin_amdgcn_s_setprio(0); } while (0)
#define PG8_WAIT_V(n) asm volatile("s_waitcnt vmcnt(" #n ")" ::: "memory")
#define PG8_WAIT_L(n) asm volatile("s_waitcnt lgkmcnt(" #n ")" ::: "memory")
#define PG8_BAR __builtin_amdgcn_s_barrier()
#define PG8_SCHED __builtin_amdgcn_sched_barrier(0)
    Unit cur, nxt; int ui = 0;
    if (!S.next(0, cur)) return;
    f32x4 acc[2][2][4][2];
#pragma unroll
    for (int a = 0; a < 2; ++a)
#pragma unroll
        for (int b = 0; b < 2; ++b)
#pragma unroll
            for (int m = 0; m < 4; ++m)
#pragma unroll
                for (int n = 0; n < 2; ++n) acc[a][b][m][n] = (f32x4){0.f, 0.f, 0.f, 0.f};
    bf16x8 At[4][2], B0[2][2], B1[2][2];
    const char* cA = (const char*)g.A + (size_t)cur.br * g.abr + (size_t)cur.pm * tstep; const char* cB = (const char*)g.Bt + (size_t)cur.br * g.bbr + (size_t)cur.pn * tstep;

    if constexpr (SP2) {
        PG8_STAGE(PG8_SB(0, 0), cB, voffB); PG8_STAGE(PG8_SB(0, 1), cB + hstep, voffB); PG8_STAGE(PG8_SA(0, 0), cA, voffA); PG8_STAGE(PG8_SA(0, 1), cA + hstep, voffA);
        if (wr == 1) PG8_BAR;
        PG8_WAIT_V(2); PG8_BAR;
        PG8_STAGE(PG8_SB(1, 0), cB + kstep, voffB); PG8_STAGE(PG8_SA(1, 0), cA + kstep, voffA); PG8_STAGE(PG8_SB(1, 1), cB + hstep + kstep, voffB);
        PG8_WAIT_V(6); PG8_BAR;
    } else {
        PG8_STAGE(PG8_SB(0, 0), cB, voffB); PG8_STAGE(PG8_SA(0, 0), cA, voffA); PG8_STAGE(PG8_SB(0, 1), cB + hstep, voffB); PG8_STAGE(PG8_SA(0, 1), cA + hstep, voffA);
        if (wr == 1) PG8_BAR;
        PG8_WAIT_V(4); PG8_BAR;
        PG8_STAGE(PG8_SB(1, 0), cB + kstep, voffB); PG8_STAGE(PG8_SA(1, 0), cA + kstep, voffA); PG8_STAGE(PG8_SB(1, 1), cB + hstep + kstep, voffB);
        PG8_WAIT_V(6); PG8_BAR;
    }
    for (;;) {
        const bool has_next = S.next(ui + 1, nxt);
        const char* nA = has_next ? (const char*)g.A + (size_t)nxt.br * g.abr + (size_t)nxt.pm * tstep : cA; const char* nB = has_next ? (const char*)g.Bt + (size_t)nxt.br * g.bbr + (size_t)nxt.pn * tstep : cB;
        for (int t = 0; t < nt; t += 2) {
            const bool last = (t == nt - 2);
            const char* a1 = cA + (size_t)(t + 1) * kstep;
            const char* a2 = last ? nA : cA + (size_t)(t + 2) * kstep; const char* b2 = last ? nB : cB + (size_t)(t + 2) * kstep;
            const char* a3 = a2 + kstep; const char* b3 = b2 + kstep;

            if constexpr (SP2) {
            PG8_LDB(B0, 0, 0); PG8_LDB(B1, 0, 1); PG8_SCHED; PG8_LDA(At, 0, 0); PG8_STAGE(PG8_SA(1, 1), a1 + hstep, voffA);
            PG8_WAIT_V(8); PG8_WAIT_L(0); PG8_BAR; PG8_MMA(0, 0, At, B0); PG8_MMA(0, 1, At, B1); PG8_BAR; PG8_SCHED;
            PG8_LDA(At, 0, 1); PG8_STAGE(PG8_SB(0, 0), b2, voffB); PG8_STAGE(PG8_SB(0, 1), b2 + hstep, voffB); PG8_STAGE(PG8_SA(0, 0), a2, voffA);
            PG8_WAIT_V(8); PG8_WAIT_L(0); PG8_BAR; PG8_MMA(1, 0, At, B0); PG8_MMA(1, 1, At, B1); PG8_BAR; PG8_SCHED;
            PG8_LDB(B0, 1, 0); PG8_LDB(B1, 1, 1); PG8_SCHED; PG8_LDA(At, 1, 0); PG8_STAGE(PG8_SA(0, 1), a2 + hstep, voffA);
            PG8_WAIT_V(8); PG8_WAIT_L(0); PG8_BAR; PG8_MMA(0, 0, At, B0); PG8_MMA(0, 1, At, B1); PG8_BAR; PG8_SCHED;
            PG8_LDA(At, 1, 1); PG8_STAGE(PG8_SB(1, 0), b3, voffB); PG8_STAGE(PG8_SB(1, 1), b3 + hstep, voffB); PG8_STAGE(PG8_SA(1, 0), a3, voffA);
            PG8_WAIT_V(8); PG8_WAIT_L(0); PG8_BAR; PG8_MMA(1, 0, At, B0); PG8_MMA(1, 1, At, B1); PG8_BAR; PG8_SCHED;
            } else {
            PG8_LDB(B0, 0, 0); PG8_SCHED; PG8_LDA(At, 0, 0); PG8_STAGE(PG8_SA(1, 1), a1 + hstep, voffA);
            PG8_WAIT_L(8); PG8_BAR; PG8_WAIT_L(0); PG8_MMA(0, 0, At, B0); PG8_BAR; PG8_SCHED;
            PG8_LDB(B1, 0, 1); PG8_STAGE(PG8_SB(0, 0), b2, voffB);
            PG8_BAR; PG8_WAIT_L(0); PG8_MMA(0, 1, At, B1); PG8_BAR;
            PG8_LDA(At, 0, 1); PG8_STAGE(PG8_SA(0, 0), a2, voffA);
            PG8_BAR; PG8_WAIT_L(0); PG8_MMA(1, 0, At, B0); PG8_BAR; PG8_SCHED;
            PG8_STAGE(PG8_SB(0, 1), b2 + hstep, voffB);
            PG8_WAIT_V(6); PG8_BAR; PG8_MMA(1, 1, At, B1); PG8_BAR;
            PG8_LDB(B0, 1, 0); PG8_SCHED; PG8_LDA(At, 1, 0); PG8_STAGE(PG8_SA(0, 1), a2 + hstep, voffA);
            PG8_WAIT_L(8); PG8_BAR; PG8_WAIT_L(0); PG8_MMA(0, 0, At, B0); PG8_BAR; PG8_SCHED;
            PG8_LDB(B1, 1, 1); PG8_STAGE(PG8_SB(1, 0), b3, voffB);
            PG8_BAR; PG8_WAIT_L(0); PG8_MMA(0, 1, At, B1); PG8_BAR;
            PG8_LDA(At, 1, 1); PG8_STAGE(PG8_SA(1, 0), a3, voffA);
            PG8_BAR; PG8_WAIT_L(0); PG8_MMA(1, 0, At, B0); PG8_BAR; PG8_SCHED;
            PG8_STAGE(PG8_SB(1, 1), b3 + hstep, voffB);
            PG8_WAIT_V(6); PG8_BAR; PG8_MMA(1, 1, At, B1); PG8_BAR;
            }
        }
        if constexpr (ALIGN_EPI) { if (wr == 0) PG8_BAR; }
        E(acc, cur, wr, wc, fr, fq);
        if (!has_next) break;
#pragma unroll
        for (int a = 0; a < 2; ++a)
#pragma unroll
            for (int b = 0; b < 2; ++b)
#pragma unroll
                for (int m = 0; m < 4; ++m)
#pragma unroll
                    for (int n = 0; n < 2; ++n) acc[a][b][m][n] = (f32x4){0.f, 0.f, 0.f, 0.f};
        cur = nxt; cA = nA; cB = nB; ++ui;
        if constexpr (ALIGN_EPI) { if (wr == 1) PG8_BAR; }
    }
    PG8_WAIT_V(0);
    if constexpr (!ALIGN_EPI) { if (wr == 0) PG8_BAR; }
    PG8_BAR;

#undef PG8_SA
#undef PG8_SB
#undef PG8_STAGE
#undef PG8_LDA
#undef PG8_LDB
#undef PG8_MMA
#undef PG8_WAIT_V
#undef PG8_WAIT_L
#undef PG8_BAR
#undef PG8_SCHED
}
}

#define LAS __attribute__((address_space(3)))
typedef unsigned short bf16_t;
typedef short bf16x8 __attribute__((ext_vector_type(8)));
typedef short s16x4 __attribute__((ext_vector_type(4)));
typedef float f32x4 __attribute__((ext_vector_type(4)));
typedef float f32x2 __attribute__((ext_vector_type(2)));
typedef float f32x16 __attribute__((ext_vector_type(16)));
typedef unsigned u32x4 __attribute__((ext_vector_type(4)));
typedef unsigned u32x2 __attribute__((ext_vector_type(2)));
typedef __bf16 bf16x2_t __attribute__((ext_vector_type(2)));
typedef short v4i16_t __attribute__((ext_vector_type(4)));

__device__ __forceinline__ unsigned cvtpk(float lo, float hi) { f32x2 v = {lo, hi}; bf16x2_t b = __builtin_convertvector(v, bf16x2_t); return __builtin_bit_cast(unsigned, b); }
__device__ __forceinline__ float bflo(unsigned w) { return __uint_as_float(w << 16); }
__device__ __forceinline__ float bfhi(unsigned w) { return __uint_as_float(w & 0xffff0000u); }
__device__ __forceinline__ float silu_(float x) { return x * __builtin_amdgcn_rcpf(1.0f + __builtin_amdgcn_exp2f(-x * LOG2E)); }
__device__ __forceinline__ float wave_sum(float v) {
#pragma unroll
    for (int o = 1; o < 64; o <<= 1) v += __shfl_xor(v, o);
    return v;
}

__device__ __forceinline__ void transpose_item(const float* W, int K, int N, bf16_t* WT, const float* g, LAS float* scr, int item, int lane) {
    const int nblk = N / 32, kb = item / nblk, nb = item % nblk, k0 = 64 * kb, n0 = 32 * nb;
    float wv[32], gl[32];
#pragma unroll
    for (int i = 0; i < 32; ++i) { const int kk = 2 * i + (lane >> 5); wv[i] = W[(size_t)(k0 + kk) * N + n0 + (lane & 31)]; gl[i] = g ? g[k0 + kk] : 1.0f; }
#pragma unroll
    for (int i = 0; i < 32; ++i) { const int kk = 2 * i + (lane >> 5); scr[kk * 33 + (lane & 31)] = wv[i] * gl[i]; }
    asm volatile("s_waitcnt lgkmcnt(0)" ::: "memory");
    const int c = lane & 7;
#pragma unroll
    for (int j = 0; j < 4; ++j) { const int n = (lane >> 3) + 8 * j; const LAS float* s = scr + (8 * c) * 33 + n;
        u32x4 o; o.x = cvtpk(s[0 * 33], s[1 * 33]); o.y = cvtpk(s[2 * 33], s[3 * 33]); o.z = cvtpk(s[4 * 33], s[5 * 33]); o.w = cvtpk(s[6 * 33], s[7 * 33]);
        *(u32x4*)(WT + (size_t)(n0 + n) * K + k0 + 8 * c) = o; }
    asm volatile("s_waitcnt lgkmcnt(0)" ::: "memory");
}
__device__ __forceinline__ void row_to_bf16(const float* xrow, bf16_t* orow, float* ss, int lane) {
    const f32x4* xr = (const f32x4*)xrow + lane; float s = 0.f;
    u32x2* o8 = (u32x2*)orow + lane;
    f32x4 vv[4];
#pragma unroll
    for (int j = 0; j < 4; ++j) vv[j] = xr[64 * j];
#pragma unroll
    for (int j = 0; j < 4; ++j) { const f32x4 v = vv[j]; s += (v.x * v.x + v.y * v.y) + (v.z * v.z + v.w * v.w); u32x2 w; w.x = cvtpk(v.x, v.y); w.y = cvtpk(v.z, v.w); o8[64 * j] = w; }
    s = wave_sum(s);
    if (lane == 0) *ss = s;
}
__device__ __forceinline__ void final_norm_row(float* xrow, const float* ss, const float* g, int lane) {
    f32x4* xr = (f32x4*)xrow + lane; const f32x4* gr = (const f32x4*)g + lane;
    const float rs = rsqrtf(*ss * (1.0f / 1024.0f) + RMS_EPS);
    f32x4 vv[4], gv[4];
#pragma unroll
    for (int j = 0; j < 4; ++j) { vv[j] = xr[64 * j]; gv[j] = gr[64 * j]; }
#pragma unroll
    for (int j = 0; j < 4; ++j) xr[64 * j] = vv[j] * rs * gv[j];
}

__device__ __forceinline__ s16x4 vtr(const LAS char* p) { return __builtin_bit_cast(s16x4, __builtin_amdgcn_ds_read_tr16_b64_v4i16((LAS v4i16_t*)p)); }

template <int NDB, int NKG>
__device__ __forceinline__ void softmax_pv(f32x16& s, float& m, float& l, f32x16 (&o)[NDB], const LAS char* vtile, int kg0, int troff) {
    float rm = fmaxf(s[0], s[1]);
#pragma unroll
    for (int r = 2; r < 16; ++r) rm = fmaxf(rm, s[r]);
    rm = fmaxf(rm, __shfl_xor(rm, 32));
    const float mn = fmaxf(m, rm);
    if (__any(rm > m + 8.0f)) {
        const float alpha = __builtin_amdgcn_exp2f(m - mn);
        l *= alpha;
#pragma unroll
        for (int db = 0; db < NDB; ++db) o[db] = o[db] * alpha;
        m = mn;
    }
    float ps = 0.f;
#pragma unroll
    for (int r = 0; r < 16; ++r) { s[r] = __builtin_amdgcn_exp2f(s[r] - m); ps += s[r]; }
    l += ps;
    bf16x8 pf[2];
#pragma unroll
    for (int st = 0; st < 2; ++st) { u32x4 w; w.x = cvtpk(s[8 * st + 0], s[8 * st + 1]); w.y = cvtpk(s[8 * st + 2], s[8 * st + 3]); w.z = cvtpk(s[8 * st + 4], s[8 * st + 5]); w.w = cvtpk(s[8 * st + 6], s[8 * st + 7]); pf[st] = __builtin_bit_cast(bf16x8, w); }
    s16x4 vlo[NDB][2], vhi[NDB][2];
#pragma unroll
    for (int db = 0; db < NDB; ++db)
#pragma unroll
        for (int st = 0; st < 2; ++st) { const LAS char* p = vtile + (db * NKG + kg0 + st) * 1024 + troff; vlo[db][st] = vtr(p); vhi[db][st] = vtr(p + 512); }
    __builtin_amdgcn_sched_barrier(0);
#pragma unroll
    for (int st = 0; st < 2; ++st)
#pragma unroll
        for (int db = 0; db < NDB; ++db) {
            const bf16x8 vf = {vlo[db][st][0], vlo[db][st][1], vlo[db][st][2], vlo[db][st][3], vhi[db][st][0], vhi[db][st][1], vhi[db][st][2], vhi[db][st][3]};
            o[db] = __builtin_amdgcn_mfma_f32_32x32x16_bf16(vf, pf[st], o[db], 0, 0, 0);
        }
}

struct WSeg { const bf16_t* q; size_t qstride; const bf16_t* k; const bf16_t* v; size_t kstride; int qsub0, qstep, L, W; float nslope2; };
__device__ __forceinline__ void wave_banded(const WSeg& g, LAS char* vl, float& m, float& l, f32x16 (&o)[2], int lane) {
    const int r = lane & 31, hh = lane >> 5;
    bf16x8 qf[4];
    { const bf16_t* qp = g.q + (size_t)r * g.qstride + 8 * hh;
#pragma unroll
      for (int ks = 0; ks < 4; ++ks) qf[ks] = *(const bf16x8*)(qp + 16 * ks); }
    const int qsub = g.qsub0 + r * g.qstep;
    int lo = g.qsub0 - g.W; if (lo < 0) lo = 0;
    int hi = g.qsub0 + 31 * g.qstep + g.W; if (hi > g.L - 1) hi = g.L - 1;
    const int kt_lo = lo >> 5, kt_hi = hi >> 5;
    const int vrow = lane >> 3, vc8 = lane & 7;
    const int vwoff = ((vc8 >> 2) * 2) * 1024 + (vc8 & 3) * 16;
    const int troff = (4 * hh + ((lane & 15) >> 2)) * 64 + (((lane >> 4) & 1) * 16 + (lane & 3) * 4) * 2;
    const float wf = (float)g.W;
    LAS char* kl = vl + 4096;
    u32x4 ka[4], va[4], kb[4], vb[4];
#define WB_LOAD(KR, VR, KT) do { const int k0_ = (KT) * 32; \
        _Pragma("unroll") for (int i = 0; i < 4; ++i) { const size_t ro_ = (size_t)(k0_ + vrow + 8 * i) * g.kstride + vc8 * 8; KR[i] = *(const u32x4*)(g.k + ro_); VR[i] = *(const u32x4*)(g.v + ro_); } } while (0)
#define WB_STEP(KR, VR, KT) do { \
        asm volatile("" ::: "memory"); \
        _Pragma("unroll") for (int i = 0; i < 4; ++i) { const int row = vrow + 8 * i; *(LAS u32x4*)(vl + vwoff + (row >> 4) * 1024 + (row & 15) * 64) = VR[i]; *(LAS u32x4*)(kl + vc8 * 528 + row * 16) = KR[i]; } \
        asm volatile("" ::: "memory"); \
        bf16x8 kf[4]; \
        _Pragma("unroll") for (int ks = 0; ks < 4; ++ks) kf[ks] = *(const LAS bf16x8*)(kl + (2 * ks + hh) * 528 + r * 16); \
        f32x16 s = {0.f, 0.f, 0.f, 0.f, 0.f, 0.f, 0.f, 0.f, 0.f, 0.f, 0.f, 0.f, 0.f, 0.f, 0.f, 0.f}; \
        _Pragma("unroll") for (int ks = 0; ks < 4; ++ks) s = __builtin_amdgcn_mfma_f32_32x32x16_bf16(kf[ks], qf[ks], s, 0, 0, 0); \
        const float dq = (float)(qsub - (KT) * 32 - 4 * hh); \
        _Pragma("unroll") for (int rg = 0; rg < 16; ++rg) { const float cr = (float)((rg & 3) + 8 * (rg >> 2)); const float d = fabsf(dq - cr); const float v = s[rg] + g.nslope2 * d; s[rg] = (d <= wf) ? v : -1e30f; } \
        softmax_pv<2, 2>(s, m, l, o, vl, 0, troff); \
        asm volatile("" ::: "memory"); } while (0)
    WB_LOAD(ka, va, kt_lo);
    if (kt_lo + 1 <= kt_hi) WB_LOAD(kb, vb, kt_lo + 1);
    for (int kt = kt_lo; kt <= kt_hi; kt += 2) {
        WB_STEP(ka, va, kt);
        if (kt + 2 <= kt_hi) WB_LOAD(ka, va, kt + 2);
        if (kt + 1 <= kt_hi) {
            WB_STEP(kb, vb, kt + 1);
            if (kt + 3 <= kt_hi) WB_LOAD(kb, vb, kt + 3);
        }
    }
#undef WB_STEP
#undef WB_LOAD
}
__device__ __forceinline__ void wave_store64(const f32x16 (&o)[2], float l, const bf16_t* gate, bf16_t* dst, int lane) {
    const int hh = lane >> 5;
    u32x2 gw[2][4];
#pragma unroll
    for (int db = 0; db < 2; ++db)
#pragma unroll
        for (int g4 = 0; g4 < 4; ++g4) gw[db][g4] = *(const u32x2*)(gate + 32 * db + 8 * g4 + 4 * hh);
    l += __shfl_xor(l, 32);
    const float inv = 1.0f / l;
#pragma unroll
    for (int db = 0; db < 2; ++db)
#pragma unroll
        for (int g4 = 0; g4 < 4; ++g4) { const int dv = 32 * db + 8 * g4 + 4 * hh;
            u32x2 w; w.x = cvtpk(o[db][4 * g4 + 0] * inv * silu_(bflo(gw[db][g4].x)), o[db][4 * g4 + 1] * inv * silu_(bfhi(gw[db][g4].x)));
            w.y = cvtpk(o[db][4 * g4 + 2] * inv * silu_(bflo(gw[db][g4].y)), o[db][4 * g4 + 3] * inv * silu_(bfhi(gw[db][g4].y)));
            *(u32x2*)(dst + dv) = w; }
}
constexpr int WV_LDS = 8320, A_ACC = 8 * WV_LDS, A_TOKB = 136, A_LSE = A_ACC + 512 * A_TOKB;
__device__ __forceinline__ void attn_A_span(const bf16_t* P, bf16_t* act_a, int S, int seqbase, int tl0, int h, LAS char* lds, int wave, int lane) {
    LAS char* vl = lds + wave * WV_LDS;
    const int r = lane & 31, hh = lane >> 5;
#pragma unroll 1
    for (int g = 0; g < 3; ++g) {
        const int sh = 2 * g, dil = 1 << sh, gh = g * 8 + h;
        const float nslope2 = -exp2f(-(float)(gh + 1) * (1.0f / 3.0f)) * (float)dil * LOG2E;
#pragma unroll 1
        for (int rep = 0; rep < 2; ++rep) {
            const int it = wave + 8 * rep, rho = it & (dil - 1), j = it >> sh;
            float m = -30000.f, l = 0.f; f32x16 o[2];
#pragma unroll
            for (int i = 0; i < 16; ++i) { o[0][i] = 0.f; o[1][i] = 0.f; }
            WSeg sg;
            sg.q = P + PB(QA + gh * 64) + (size_t)(seqbase + tl0 + rho + dil * 32 * j) * 64; sg.qstride = (size_t)dil * 64;
            sg.k = P + PB(KA + gh * 64) + (size_t)(seqbase + rho) * 64; sg.v = P + PB(VA + gh * 64) + (size_t)(seqbase + rho) * 64; sg.kstride = (size_t)dil * 64;
            sg.qsub0 = (tl0 >> sh) + 32 * j; sg.qstep = 1; sg.L = S >> sh; sg.W = 64; sg.nslope2 = nslope2;
            wave_banded(sg, vl, m, l, o, lane);
            l += __shfl_xor(l, 32);
            const float inv = 1.0f / l;
            float lse = m + __builtin_amdgcn_logf(l);
            const int ti = rho + dil * (32 * j + r);
            LAS char* ap = lds + A_ACC + ti * A_TOKB + 8 * hh;
            LAS float* lp = (LAS float*)(lds + A_LSE) + ti;
            float wa = 0.f, wb = inv;
            if (g > 0) {
                const float lse_a = *lp; const float mx = fmaxf(lse_a, lse);
                const float ea = __builtin_amdgcn_exp2f(lse_a - mx), eb = __builtin_amdgcn_exp2f(lse - mx);
                const float den = 1.0f / (ea + eb);
                wa = ea * den; wb = eb * den * inv;
                lse = mx + __builtin_amdgcn_logf(ea + eb);
            }
            const int tok = seqbase + tl0 + ti;
            const bf16_t* gate = P + PB(GA + h * 64) + (size_t)tok * 64;
            bf16_t* dst = act_a + (size_t)tok * 512 + h * 64;
            u32x2 gwv[2][4];
            if (g == 2) {
#pragma unroll
                for (int db = 0; db < 2; ++db)
#pragma unroll
                    for (int g4 = 0; g4 < 4; ++g4) gwv[db][g4] = *(const u32x2*)(gate + 32 * db + 8 * g4 + 4 * hh);
            }
#pragma unroll
            for (int db = 0; db < 2; ++db)
#pragma unroll
                for (int g4 = 0; g4 < 4; ++g4) {
                    float v0 = o[db][4 * g4 + 0] * wb, v1 = o[db][4 * g4 + 1] * wb, v2 = o[db][4 * g4 + 2] * wb, v3 = o[db][4 * g4 + 3] * wb;
                    LAS u32x2* a2 = (LAS u32x2*)(ap + 64 * db + 16 * g4);
                    if (g > 0) { const u32x2 pa = *a2; v0 += wa * bflo(pa.x); v1 += wa * bfhi(pa.x); v2 += wa * bflo(pa.y); v3 += wa * bfhi(pa.y); }
                    if (g < 2) { u32x2 w; w.x = cvtpk(v0, v1); w.y = cvtpk(v2, v3); *a2 = w; }
                    else { const int dv = 32 * db + 8 * g4 + 4 * hh; const u32x2 gw = gwv[db][g4];
                        u32x2 w; w.x = cvtpk(v0 * silu_(bflo(gw.x)), v1 * silu_(bfhi(gw.x))); w.y = cvtpk(v2 * silu_(bflo(gw.y)), v3 * silu_(bfhi(gw.y))); *(u32x2*)(dst + dv) = w; }
                }
            if (g < 2 && hh == 0) *lp = lse;
        }
        __syncthreads();
    }
}
__device__ __forceinline__ void attn_B_wave(const bf16_t* P, bf16_t* act_b, int S, int seqbase, int t0, int hq, float sink, LAS char* vl, int lane) {
    float m = sink * LOG2E, l = (lane < 32) ? 1.0f : 0.0f; f32x16 o[2];
#pragma unroll
    for (int i = 0; i < 16; ++i) { o[0][i] = 0.f; o[1][i] = 0.f; }
    const int kvh = hq >> 2;
    WSeg sg;
    sg.q = P + PB(QB + hq * 64) + (size_t)(seqbase + t0) * 64; sg.qstride = (size_t)64;
    sg.k = P + PB(KB + kvh * 64) + (size_t)seqbase * 64; sg.v = P + PB(VB + kvh * 64) + (size_t)seqbase * 64; sg.kstride = (size_t)64;
    sg.qsub0 = t0; sg.qstep = 1; sg.L = S; sg.W = 128;
    sg.nslope2 = -exp2f(-(float)(hq + 1)) * LOG2E;
    wave_banded(sg, vl, m, l, o, lane);
    const int tok = seqbase + t0 + (lane & 31);
    wave_store64(o, l, P + PB(GB + hq * 64) + (size_t)tok * 64, act_b + (size_t)tok * 512 + hq * 64, lane);
}

constexpr int C_KCS = 1024, C_K2 = 8 * C_KCS, C_V = 2 * 8 * C_KCS, C_BUF = C_V + 16384;
__device__ __forceinline__ void attn_C_item(const bf16_t* P, bf16_t* act_c, int S, int seqbase, int q0, int h, float lam, float oml, const float* subln_g, LAS char* lds, int tid, int w, int lane) {
    const int map = w >> 2, qrow = q0 + 32 * (w & 3), r = lane & 31, hh = lane >> 5;
    bf16x8 qf[4];
    { const bf16_t* qp = P + PB(QC + (h * 2 + map) * 64) + (size_t)(seqbase + qrow + r) * 64 + 8 * hh;
#pragma unroll
      for (int ks = 0; ks < 4; ++ks) qf[ks] = *(const bf16x8*)(qp + 16 * ks); }
    const float nslope2 = -exp2f(-2.0f * (float)(h + 1)) * LOG2E;
    const int NT = S / 64;
    const bf16_t* k1src = P + PB(KC + (h * 2) * 64) + (size_t)(seqbase + 8 * w + (lane >> 3)) * 64 + (((lane & 7) ^ ((lane >> 3) & 7)) * 8);
    const bf16_t* v0src = P + PB(VC + h * 128) + (size_t)(seqbase + (w & 3) * 16 + (lane >> 2)) * 64 + (w >> 2) * 32 + (lane & 3) * 8;
    (void)tid;
    const int troff = (4 * hh + ((lane & 15) >> 2)) * 64 + (((lane >> 4) & 1) * 16 + (lane & 3) * 4) * 2;
    const int kroff = map * C_K2 + r * 128, ksw = r & 7;
    float m = 0.f, l = 0.f; f32x16 o[4];
#pragma unroll
    for (int i = 0; i < 16; ++i) { o[0][i] = 0.f; o[1][i] = 0.f; o[2][i] = 0.f; o[3][i] = 0.f; }
    f32x16 negm;
#pragma unroll
    for (int i = 0; i < 16; ++i) negm[i] = 0.f;
#define C_GLDS(GSRC, LOFF) do { unsigned keep_; const unsigned ld_ = (unsigned)__builtin_amdgcn_readfirstlane((int)(lds0 + (unsigned)(LOFF))); \
        asm volatile("s_mov_b32 %0, m0\n\ts_mov_b32 m0, %2\n\ts_nop 0\n\tglobal_load_lds_dwordx4 %1, off\n\ts_mov_b32 m0, %0" : "=&s"(keep_) : "v"(GSRC), "s"(ld_) : "memory"); } while (0)
#define C_DMA(T, B) do { const size_t ro_ = (size_t)(T) * 64 * 64; const int d_ = (B) * C_BUF; \
        C_GLDS(k1src + ro_, d_ + w * C_KCS); C_GLDS(k1src + ro_ + (size_t)MC * 64, d_ + C_K2 + w * C_KCS); \
        C_GLDS(v0src + ro_, d_ + C_V + w * 1024); C_GLDS(v0src + ro_ + (size_t)MC * 64, d_ + C_V + (w + 8) * 1024); } while (0)
    const unsigned lds0 = (unsigned)(uintptr_t)lds;
    const int qpos = qrow + r;
    bf16x8 pf[4]; bool pvalid = false;
    auto pv = [&](const LAS char* buf) __attribute__((always_inline)) {
            if (pvalid) {
                const LAS char* vt = buf + C_V + troff;
                s16x4 vlo[2][4], vhi[2][4];
#define PV_RD(ST, SET) do { _Pragma("unroll") for (int db = 0; db < 4; ++db) { const LAS char* p = vt + (db * 4 + (ST)) * 1024; vlo[SET][db] = vtr(p); vhi[SET][db] = vtr(p + 512); } } while (0)
#define PV_MM(ST, SET) do { _Pragma("unroll") for (int db = 0; db < 4; ++db) { const bf16x8 vf = {vlo[SET][db][0], vlo[SET][db][1], vlo[SET][db][2], vlo[SET][db][3], vhi[SET][db][0], vhi[SET][db][1], vhi[SET][db][2], vhi[SET][db][3]}; \
                        o[db] = __builtin_amdgcn_mfma_f32_32x32x16_bf16(vf, pf[ST], o[db], 0, 0, 0); } } while (0)
                __builtin_amdgcn_s_setprio(1);
                PV_RD(0, 0); PV_RD(1, 1); __builtin_amdgcn_sched_barrier(0);
                PV_MM(0, 0); __builtin_amdgcn_sched_barrier(0);
                PV_RD(2, 0); __builtin_amdgcn_sched_barrier(0);
                PV_MM(1, 1); __builtin_amdgcn_sched_barrier(0);
                PV_RD(3, 1); __builtin_amdgcn_sched_barrier(0);
                PV_MM(2, 0); __builtin_amdgcn_sched_barrier(0);
                PV_MM(3, 1); __builtin_amdgcn_sched_barrier(0);
                __builtin_amdgcn_s_setprio(0);
#undef PV_RD
#undef PV_MM
            }
    };
    f32x16 s0, s1; float rm = 0.f;
    auto qk = [&](const LAS char* buf) __attribute__((always_inline)) {
            s0 = negm; s1 = negm;
            bf16x8 kfa[4], kfb[4];
#pragma unroll
            for (int ks = 0; ks < 4; ++ks) { const int co = ((2 * ks + hh) ^ ksw) << 4; kfa[ks] = *(const LAS bf16x8*)(buf + kroff + co); kfb[ks] = *(const LAS bf16x8*)(buf + kroff + co + 4096); }
            __builtin_amdgcn_sched_barrier(0);
            __builtin_amdgcn_s_setprio(1);
#pragma unroll
            for (int ks = 0; ks < 4; ++ks) {
                s0 = __builtin_amdgcn_mfma_f32_32x32x16_bf16(kfa[ks], qf[ks], s0, 0, 0, 0);
                s1 = __builtin_amdgcn_mfma_f32_32x32x16_bf16(kfb[ks], qf[ks], s1, 0, 0, 0);
            }
            __builtin_amdgcn_s_setprio(0);
            __builtin_amdgcn_sched_barrier(0);
    };
#define C_BIASMAX(T) do { const float dq_ = (float)(qpos - (T) * 64 - 4 * hh); \
            _Pragma("unroll") for (int rg = 0; rg < 16; ++rg) { const float cr = (float)((rg & 3) + 8 * (rg >> 2)); s0[rg] = s0[rg] + nslope2 * fabsf(dq_ - cr); s1[rg] = s1[rg] + nslope2 * fabsf(dq_ - (cr + 32.0f)); } \
            rm = fmaxf(fmaxf(s0[0], s0[1]), fmaxf(s1[0], s1[1])); \
            _Pragma("unroll") for (int rg = 2; rg < 16; ++rg) rm = fmaxf(rm, fmaxf(s0[rg], s1[rg])); } while (0)
    auto fin = [&](const bool first) __attribute__((always_inline)) {
            { auto rr = __builtin_amdgcn_permlane32_swap(__float_as_uint(rm), __float_as_uint(rm), false, false); rm = fmaxf(__uint_as_float(rr[0]), __uint_as_float(rr[1])); }
            pvalid = first || !__all(rm < -150.0f);
            if (pvalid) {
                if (first || __any(rm > 8.0f)) {
                    const float dl = first ? rm : fmaxf(rm, 0.0f); m += dl;
                    if (!first) { const float alpha = __builtin_amdgcn_exp2f(-dl); l *= alpha;
#pragma unroll
                    for (int db = 0; db < 4; ++db) o[db] = o[db] * alpha; }
#pragma unroll
                    for (int rg = 0; rg < 16; ++rg) { s0[rg] -= dl; s1[rg] -= dl; negm[rg] = -m; }
                }
                float ps0 = 0.f, ps1 = 0.f;
#pragma unroll
                for (int rg = 0; rg < 16; ++rg) { s0[rg] = __builtin_amdgcn_exp2f(s0[rg]); s1[rg] = __builtin_amdgcn_exp2f(s1[rg]); ps0 += s0[rg]; ps1 += s1[rg]; }
                l += ps0 + ps1;
#pragma unroll
                for (int st = 0; st < 2; ++st) {
                    u32x4 wa, wb;
                    wa.x = cvtpk(s0[8 * st + 0], s0[8 * st + 1]); wa.y = cvtpk(s0[8 * st + 2], s0[8 * st + 3]); wa.z = cvtpk(s0[8 * st + 4], s0[8 * st + 5]); wa.w = cvtpk(s0[8 * st + 6], s0[8 * st + 7]);
                    wb.x = cvtpk(s1[8 * st + 0], s1[8 * st + 1]); wb.y = cvtpk(s1[8 * st + 2], s1[8 * st + 3]); wb.z = cvtpk(s1[8 * st + 4], s1[8 * st + 5]); wb.w = cvtpk(s1[8 * st + 6], s1[8 * st + 7]);
                    pf[st] = __builtin_bit_cast(bf16x8, wa); pf[2 + st] = __builtin_bit_cast(bf16x8, wb);
                }
            }
    };
    auto pv_bm = [&](const LAS char* bufp, const int T) __attribute__((always_inline)) {
            const LAS char* vt = bufp + C_V + troff;
            s16x4 vlo[2][4], vhi[2][4];
#define PV_RD(ST, SET) do { _Pragma("unroll") for (int db = 0; db < 4; ++db) { const LAS char* p = vt + (db * 4 + (ST)) * 1024; vlo[SET][db] = vtr(p); vhi[SET][db] = vtr(p + 512); } } while (0)
#define PV_MM(ST, SET) do { _Pragma("unroll") for (int db = 0; db < 4; ++db) { const bf16x8 vf = {vlo[SET][db][0], vlo[SET][db][1], vlo[SET][db][2], vlo[SET][db][3], vhi[SET][db][0], vhi[SET][db][1], vhi[SET][db][2], vhi[SET][db][3]}; \
                        o[db] = __builtin_amdgcn_mfma_f32_32x32x16_bf16(vf, pf[ST], o[db], 0, 0, 0); } } while (0)
            __builtin_amdgcn_sched_barrier(0);
            PV_RD(0, 0); PV_RD(1, 1);
            C_BIASMAX(T);
            PV_MM(0, 0); PV_RD(2, 0); PV_MM(1, 1); PV_RD(3, 1); PV_MM(2, 0); PV_MM(3, 1);
            __builtin_amdgcn_sched_group_barrier(0x100, 16, 0);
#pragma unroll
            for (int i = 0; i < 4; ++i) { __builtin_amdgcn_sched_group_barrier(0x008, 1, 0); __builtin_amdgcn_sched_group_barrier(0x002, 6, 0); }
            __builtin_amdgcn_sched_group_barrier(0x100, 8, 0);
#pragma unroll
            for (int i = 0; i < 4; ++i) { __builtin_amdgcn_sched_group_barrier(0x008, 1, 0); __builtin_amdgcn_sched_group_barrier(0x002, 6, 0); }
            __builtin_amdgcn_sched_group_barrier(0x100, 8, 0);
#pragma unroll
            for (int i = 0; i < 8; ++i) { __builtin_amdgcn_sched_group_barrier(0x008, 1, 0); __builtin_amdgcn_sched_group_barrier(0x002, 6, 0); }
            __builtin_amdgcn_sched_barrier(0);
#undef PV_RD
#undef PV_MM
    };
    const int td = q0 >> 6;
#define TSEQ(I) (((I) < NT - td) ? td + (I) : NT - 1 - (I))
    C_DMA(TSEQ(0), 0); C_DMA(TSEQ(1), 1);
    for (int t = 0; t < NT; ++t) {
        if (t + 1 < NT) asm volatile("s_waitcnt vmcnt(4)\n\ts_barrier" ::: "memory"); else asm volatile("s_waitcnt vmcnt(0)\n\ts_barrier" ::: "memory");
        if (t + 2 < NT) C_DMA(TSEQ(t + 2), (t + 2) & 3);
        const int T = TSEQ(t);
        qk((const LAS char*)lds + (t & 3) * C_BUF);
        if (t > 0 && pvalid) pv_bm((const LAS char*)lds + ((t - 1) & 3) * C_BUF, T); else C_BIASMAX(T);
        fin(t == 0);
    }
    pv((const LAS char*)lds + ((NT - 1) & 3) * C_BUF);
#undef C_BIASMAX
    asm volatile("s_waitcnt vmcnt(0) lgkmcnt(0)\n\ts_barrier" ::: "memory");
#undef C_DMA
#undef TSEQ
#undef C_GLDS
    l += __shfl_xor(l, 32);
    const float inv = 1.0f / l;
    LAS float* xch = (LAS float*)lds + (size_t)(w & 3) * 4096 + lane;
    if (map == 1) {
#pragma unroll
        for (int db = 0; db < 4; ++db)
#pragma unroll
            for (int i = 0; i < 16; ++i) xch[(db * 16 + i) * 64] = o[db][i] * inv;
    }
    __syncthreads();
    if (map == 0) {
        float ss = 0.f;
#pragma unroll
        for (int db = 0; db < 4; ++db)
#pragma unroll
            for (int i = 0; i < 16; ++i) { const float d = o[db][i] * inv - lam * xch[(db * 16 + i) * 64]; o[db][i] = d; ss += d * d; }
        ss += __shfl_xor(ss, 32);
        const float rn = rsqrtf(ss * (1.0f / 128.0f) + RMS_EPS) * oml;
        const int tok = seqbase + qrow + r;
        const bf16_t* gate = P + PB(GC + h * 128) + (size_t)tok * 64;
        bf16_t* dst = act_c + (size_t)tok * 512 + h * 128;
#pragma unroll
        for (int dh = 0; dh < 2; ++dh) {
        u32x2 gwv[2][4]; f32x4 sgv[2][4];
#pragma unroll
        for (int db = 0; db < 2; ++db)
#pragma unroll
            for (int g4 = 0; g4 < 4; ++g4) { gwv[db][g4] = *(const u32x2*)(gate + (size_t)dh * MC * 64 + 32 * db + 8 * g4 + 4 * hh); sgv[db][g4] = *(const f32x4*)(subln_g + 32 * (2 * dh + db) + 8 * g4 + 4 * hh); }
        asm volatile("" ::: "memory");
#pragma unroll
        for (int dbl = 0; dbl < 2; ++dbl)
#pragma unroll
            for (int g4 = 0; g4 < 4; ++g4) { const int db = 2 * dh + dbl; const int dv = 32 * db + 8 * g4 + 4 * hh;
                const u32x2 gw = gwv[dbl][g4]; const f32x4 sg = sgv[dbl][g4];
                u32x2 wv; wv.x = cvtpk(o[db][4 * g4 + 0] * rn * sg.x * silu_(bflo(gw.x)), o[db][4 * g4 + 1] * rn * sg.y * silu_(bfhi(gw.x)));
                wv.y = cvtpk(o[db][4 * g4 + 2] * rn * sg.z * silu_(bflo(gw.y)), o[db][4 * g4 + 3] * rn * sg.w * silu_(bfhi(gw.y)));
                *(u32x2*)(dst + dv) = wv; }
        asm volatile("" ::: "memory");
        }
    }
    __syncthreads();
}

#define XB_TMO      128
#define XB_XCNT(j)  (256  + 64 * (j))
#define XB_XSUB(j)  (1280 + 64 * (j))
#define XB_XGEN(j)  (2304 + 64 * (j))
#define XB_TOP      3328
#define XB_TOPGEN   3392
#define XCD_BAR_WORDS 3456
#define XB_SPIN_CAP (1u << 18)

__device__ __forceinline__ unsigned xb_ld(unsigned* p)              { return __hip_atomic_load(p, __ATOMIC_RELAXED, __HIP_MEMORY_SCOPE_AGENT); }
__device__ __forceinline__ unsigned xb_add(unsigned* p, unsigned v) { return __hip_atomic_fetch_add(p, v, __ATOMIC_RELAXED, __HIP_MEMORY_SCOPE_AGENT); }
__device__ __forceinline__ unsigned xb_xcc_id() { return (unsigned)__builtin_amdgcn_s_getreg((3 << 11) | 20) & 0xFu; }
#define XB_SPIN(cond, bar) do { unsigned _sp = 0; while (cond) { __builtin_amdgcn_s_sleep(1); \
    if ((++_sp & 255u) == 0u) { if (xb_ld(&(bar)[XB_TMO])) break; if (_sp > XB_SPIN_CAP) { atomicAdd(&(bar)[XB_TMO], 1u); break; } } } } while (0)

struct XcdBarrier {
    unsigned* bar; unsigned x;
    volatile LAS unsigned* st;
};

__device__ __forceinline__ XcdBarrier xcd_barrier_post(unsigned* bar, volatile LAS unsigned* st) {
    XcdBarrier b; b.bar = bar; b.x = xb_xcc_id(); b.st = st;
    if (threadIdx.x == 0) (void)xb_add(&bar[XB_XCNT(b.x)], 1u);
    return b;
}
__device__ __forceinline__ void xcd_barrier_complete(unsigned* bar, unsigned x, unsigned& nloc, unsigned& nx) {
    const unsigned G = gridDim.x * gridDim.y * gridDim.z;
    unsigned sum, cnt, mine, sp = 0u;
    for (;;) {
        sum = 0u; cnt = 0u; mine = 0u;
#pragma unroll
        for (unsigned j = 0; j < 16; ++j) { const unsigned c = xb_ld(&bar[XB_XCNT(j)]); sum += c; cnt += (c > 0u) ? 1u : 0u; mine = (j == x) ? c : mine; }
        if (sum == G) break;
        __builtin_amdgcn_s_sleep(1);
        if ((++sp & 255u) == 0u) { if (xb_ld(&bar[XB_TMO])) break; if (sp > XB_SPIN_CAP) { atomicAdd(&bar[XB_TMO], 1u); break; } }
    }
    nloc = mine > 0u ? mine : 1u; nx = cnt > 0u ? cnt : 1u;
}

__device__ __forceinline__ void xcd_barrier(const XcdBarrier& b) {
    asm volatile("s_waitcnt vmcnt(0)" ::: "memory");
    __syncthreads();
    if (threadIdx.x == 0) {
        unsigned* bar = b.bar;
        __builtin_amdgcn_s_waitcnt(0);
        unsigned nloc = b.st[0], nx = b.st[1];
        if (nloc == 0u) { xcd_barrier_complete(bar, b.x, nloc, nx); b.st[0] = nloc; b.st[1] = nx; }
        const unsigned old = xb_add(&bar[XB_XSUB(b.x)], 1u);
        const unsigned gen = old / nloc;
        if (old + 1u == (gen + 1u) * nloc) {
            __builtin_amdgcn_fence(__ATOMIC_RELEASE, "agent");
            asm volatile("s_waitcnt vmcnt(0)" ::: "memory");
            const unsigned og = xb_add(&bar[XB_TOP], 1u);
            const unsigned tg = og / nx;
            if (og + 1u == (tg + 1u) * nx) xb_add(&bar[XB_TOPGEN], 1u);
            else XB_SPIN(xb_ld(&bar[XB_TOPGEN]) == tg, bar);
            __builtin_amdgcn_fence(__ATOMIC_ACQUIRE, "agent");
            xb_add(&bar[XB_XGEN(b.x)], 1u);
            asm volatile("s_waitcnt vmcnt(0)" ::: "memory");
        } else {
            XB_SPIN(xb_ld(&bar[XB_XGEN(b.x)]) == gen, bar);
            __builtin_amdgcn_fence(__ATOMIC_ACQUIRE, "agent");
            asm volatile("s_waitcnt vmcnt(0)" ::: "memory");
        }
    }
    __syncthreads();
}

struct Args {
    const float* x_prompt; const float* x_sample; const float* norm_g; const float* w_in; const float* w_oa; const float* w_ob; const float* w_oc; const float* w_out;
    const float* b_sink; const float* lam_q1; const float* lam_k1; const float* lam_q2; const float* lam_k2; const float* c_subln_g; const float* final_norm_g;
    float* out; unsigned char* ws;
};

typedef const __attribute__((address_space(4))) Args* KArgs;
__device__ __forceinline__ KArgs kargs() { auto p = __builtin_amdgcn_kernarg_segment_ptr(); asm volatile("" : "+s"(p)); return (KArgs)p; }

__global__ void __launch_bounds__(512, 2) fwd_kernel(Args a_unused) {
    extern __shared__ __attribute__((aligned(16))) unsigned char lds_raw[];
    LAS unsigned char* lds = (LAS unsigned char*)lds_raw;
#define OPAQUE_IDS() int tid = threadIdx.x; asm volatile("" : "+v"(tid)); const int lane = tid & 63, wave = __builtin_amdgcn_readfirstlane(tid >> 6); (void)lane; (void)wave
#define GW_ ((int)blockIdx.x * 8 + wave)
#define NGW_ ((int)gridDim.x * 8)
    if (threadIdx.x < 32) ((LAS unsigned*)(lds + MISC_BASE))[threadIdx.x] = 0u, ((LAS unsigned*)(lds + MISC_BASE))[threadIdx.x + 32] = 0u, ((LAS unsigned*)(lds + MISC_BASE))[threadIdx.x + 64] = 0u, ((LAS unsigned*)(lds + MISC_BASE))[threadIdx.x + 96] = 0u;
    __syncthreads();
    { KArgs A_ = kargs(); (void)xcd_barrier_post((unsigned*)(A_->ws + WS_BAR), (volatile LAS unsigned*)(lds + MISC_OFF)); }
#define GRID_BAR() do { KArgs A_ = kargs(); XcdBarrier b_; b_.bar = (unsigned*)(A_->ws + WS_BAR); b_.x = xb_xcc_id(); b_.st = (volatile LAS unsigned*)(lds + MISC_OFF); xcd_barrier(b_); } while (0)

    {
        OPAQUE_IDS();
        KArgs A = kargs(); unsigned char* ws = A->ws;
        bf16_t* WIN = (bf16_t*)(ws + WS_WIN); bf16_t* WO3 = (bf16_t*)(ws + WS_WO3); bf16_t* WOUT = (bf16_t*)(ws + WS_WOUT); bf16_t* XB = (bf16_t*)(ws + WS_XB); float* rowss = (float*)(ws + WS_ROWSS);
        LAS float* scr = (LAS float*)(lds + wave * 16384);
        constexpr int I_IN = 16 * 360, I_O = 8 * 32, I_OUT = 16 * 32, I_L = I_IN + 3 * I_O + I_OUT;
        for (int it = GW_; it < DEPTH * I_L; it += NGW_) {
            const int l = it / I_L; int r = it - l * I_L;
            if (r < I_IN) { transpose_item(A->w_in + (size_t)l * 1024 * 11520, 1024, 11520, WIN + (size_t)l * 11520 * 1024, A->norm_g + l * 1024, scr, r, lane); continue; } r -= I_IN;
            if (r < I_O) { transpose_item(A->w_oa + (size_t)l * 512 * 1024, 512, 1024, WO3 + (size_t)(l * 3 + 0) * 1024 * 512, nullptr, scr, r, lane); continue; } r -= I_O;
            if (r < I_O) { transpose_item(A->w_ob + (size_t)l * 512 * 1024, 512, 1024, WO3 + (size_t)(l * 3 + 1) * 1024 * 512, nullptr, scr, r, lane); continue; } r -= I_O;
            if (r < I_O) { transpose_item(A->w_oc + (size_t)l * 512 * 1024, 512, 1024, WO3 + (size_t)(l * 3 + 2) * 1024 * 512, nullptr, scr, r, lane); continue; } r -= I_O;
            transpose_item(A->w_out + (size_t)l * 1024 * 1024, 1024, 1024, WOUT + (size_t)l * 1024 * 1024, nullptr, scr, r, lane);
        }
        for (int row = GW_; row < NTOK; row += NGW_) {
            const float* src = (row < 16384) ? A->x_prompt + (size_t)row * 1024 : A->x_sample + (size_t)(row - 16384) * 1024;
            row_to_bf16(src, XB + (size_t)row * 1024, rowss + row, lane);
        }
    }
    cg::this_grid().sync();

#pragma unroll 1
    for (int c = 0; c < NCHUNK; ++c) {
#pragma unroll 1
        for (int l = 0; l < DEPTH; ++l) {
            {
                OPAQUE_IDS();
                KArgs A = kargs(); unsigned char* ws = A->ws; float* rowss = (float*)(ws + WS_ROWSS);
                const size_t crow0 = (size_t)c * MC; const int G = gridDim.x, bid = blockIdx.x;
                if (l == 0 && c > 0) { for (int row = GW_; row < MC; row += NGW_) { const size_t rr = crow0 - MC + row; final_norm_row(A->out + rr * 1024, rowss + rr, A->final_norm_g, lane); } }
                { float* rz = rowss + (size_t)((l + 1) & 1) * NTOK + crow0; for (int i = bid * 512 + tid; i < MC; i += G * 512) rz[i] = 0.f; }
#ifndef SKIP_P1
                pg8::Gemm g{(bf16_t*)(ws + WS_XB) + crow0 * 1024, (bf16_t*)(ws + WS_WIN) + (size_t)l * 11520 * 1024, MC, DIN, 1024, 0, 0};
                pg8::OrderXcd So; So.init(MC, DIN - 256, G, bid);
                pg8::EpiProj E{(bf16_t*)(ws + WS_P), rowss + (size_t)(l & 1) * NTOK + crow0};
                pg8::gemm_phase<pg8::EpiProj, pg8::OrderXcd, true, true>(lds, g, So, E);
#endif
            }
            GRID_BAR();
            {
                const int S = (c == 0) ? 8192 : 2048;
                const int G = gridDim.x, bid = blockIdx.x;
#ifndef SKIP_C
                {
                    OPAQUE_IDS();
                    KArgs A = kargs(); unsigned char* ws = A->ws;
                    const float lam_init = 0.8f - 0.6f * expf(-0.3f * (float)l);
                    float d1 = A->lam_q1[l * 64 + lane] * A->lam_k1[l * 64 + lane], d2 = A->lam_q2[l * 64 + lane] * A->lam_k2[l * 64 + lane];
                    d1 = wave_sum(d1); d2 = wave_sum(d2);
                    const float lam = expf(d1) - expf(d2) + lam_init;
                    const bf16_t* P = (const bf16_t*)(ws + WS_P); bf16_t* act_c = (bf16_t*)(ws + WS_ACT) + (size_t)2 * MC * 512;
                    const float* sg = A->c_subln_g + l * 128;
                    for (int it = bid; it < 512; it += G) {
                        const int x = it & 7, y = it >> 3; int pair, qb;
                        if (c == 0) { pair = x; qb = y; } else { pair = x + 8 * (y >> 4); qb = y & 15; }
                        const int seq = pair >> 2, h = (it & 256) ? 3 - (pair & 3) : (pair & 3);
                        attn_C_item(P, act_c, S, seq * S, qb * 128, h, lam, 1.0f - lam_init, sg, (LAS char*)lds, tid, wave, lane);
                    }
                }
#endif
#ifndef SKIP_P1
                {
                    OPAQUE_IDS();
                    KArgs A = kargs(); unsigned char* ws = A->ws; float* rowss = (float*)(ws + WS_ROWSS);
                    const size_t crow0 = (size_t)c * MC;
                    pg8::Gemm g{(bf16_t*)(ws + WS_XB) + crow0 * 1024, (bf16_t*)(ws + WS_WIN) + (size_t)l * 11520 * 1024, MC, DIN, 1024, 0, 0};
                    pg8::OrderFixed So{((bid >> 3) << 1) + ((bid >> 2) & 1), 44, (bid & 3) == 0 && bid < 256};
                    pg8::EpiProj E{(bf16_t*)(ws + WS_P), rowss + (size_t)(l & 1) * NTOK + crow0};
                    __syncthreads();
                    pg8::gemm_phase<pg8::EpiProj, pg8::OrderFixed, true, true>(lds, g, So, E);
                    __syncthreads();
                }
#endif
#ifndef SKIP_A
                {
                    OPAQUE_IDS();
                    KArgs A = kargs(); unsigned char* ws = A->ws;
                    const bf16_t* P = (const bf16_t*)(ws + WS_P); bf16_t* act_a = (bf16_t*)(ws + WS_ACT);
                    unsigned* ctr = (unsigned*)(ws + WS_BAR + 14400) + (c * 4 + l) * 16;
                    volatile LAS unsigned* slot = (volatile LAS unsigned*)(lds + MISC_BASE + 128);
                    for (;;) {
                        __syncthreads();
                        if (tid == 0) *slot = atomicAdd(ctr, 1u);
                        __syncthreads();
                        const int idx = (int)*slot;
                        if (idx >= 256) break;
                        const int span = idx >> 3, h = idx & 7;
                        const int tokb = span * 512, seq = tokb / S, tl = tokb - seq * S;
                        attn_A_span(P, act_a, S, seq * S, tl, h, (LAS char*)lds, wave, lane);
                    }
                }
#endif
#ifndef SKIP_B
                {
                    OPAQUE_IDS(); LAS char* vl = (LAS char*)lds + wave * WV_LDS;
                    KArgs A = kargs(); unsigned char* ws = A->ws;
                    const bf16_t* P = (const bf16_t*)(ws + WS_P); bf16_t* act_b = (bf16_t*)(ws + WS_ACT) + (size_t)MC * 512;
                    unsigned* ctr = (unsigned*)(ws + WS_BAR + 14400) + (c * 4 + l) * 16 + 8;
                    volatile LAS unsigned* slot = (volatile LAS unsigned*)(lds + MISC_BASE + 128);
                    for (;;) {
                        __syncthreads();
                        if (tid == 0) *slot = atomicAdd(ctr, 1u);
                        __syncthreads();
                        const int br = (int)*slot;
                        if (br >= 512) break;
                        const int span = br >> 1, hq = 4 * (br & 1) + (wave & 3);
                        const int tokb = span * 64, seq = tokb / S, tl = tokb - seq * S;
                        attn_B_wave(P, act_b, S, seq * S, tl + 32 * (wave >> 2), hq, A->b_sink[l * 8 + hq], vl, lane);
                    }
                }
#endif
            }
            GRID_BAR();
            {
#ifndef SKIP_P3
                KArgs A = kargs(); unsigned char* ws = A->ws;
                pg8::Gemm g{(bf16_t*)(ws + WS_ACT), (bf16_t*)(ws + WS_WO3) + (size_t)l * 3 * 1024 * 512, MC, 1024, 512, (size_t)MC * 512 * 2, (size_t)1024 * 512 * 2};
                pg8::OrderMix So{4, (MC / 256) * 4, (int)gridDim.x, (int)blockIdx.x};
                pg8::EpiMix E{(const bf16_t*)(ws + WS_P), (bf16_t*)(ws + WS_MIX)};
                pg8::gemm_phase<pg8::EpiMix, pg8::OrderMix, true, true>(lds, g, So, E);
#endif
            }
            GRID_BAR();
            {
#ifndef SKIP_P4
                KArgs A = kargs(); unsigned char* ws = A->ws;
                const size_t crow0 = (size_t)c * MC;
                pg8::Gemm g{(bf16_t*)(ws + WS_MIX), (bf16_t*)(ws + WS_WOUT) + (size_t)l * 1024 * 1024, MC, 1024, 1024, 0, 0};
                pg8::OrderOne So{4, (MC / 256) * 4, (int)gridDim.x, (int)blockIdx.x};
                const float* base = (l == 0) ? ((c == 0) ? A->x_prompt : A->x_sample + (size_t)(c - 1) * MC * 1024) : A->out + crow0 * 1024;
                pg8::EpiOut E{base, A->out + crow0 * 1024, (bf16_t*)(ws + WS_XB) + crow0 * 1024, (float*)(ws + WS_ROWSS) + (size_t)((l + 1) & 1) * NTOK + crow0};
                pg8::gemm_phase<pg8::EpiOut, pg8::OrderOne, true, true>(lds, g, So, E);
#endif
            }
            GRID_BAR();
        }
    }
    {
        OPAQUE_IDS();
        KArgs A = kargs(); float* rowss = (float*)(A->ws + WS_ROWSS);
        for (int row = GW_; row < MC; row += NGW_) { const size_t rr = (size_t)(NCHUNK - 1) * MC + row; final_norm_row(A->out + rr * 1024, rowss + rr, A->final_norm_g, lane); }
    }
}

extern "C" void kernel_launch(void* const* d_in, const int* in_sizes, int n_in, void* d_out, int out_size, void* d_ws, size_t ws_size, hipStream_t stream) {
    static int grid = 0;
    if (grid == 0) {
        if (n_in != 15 || out_size != NTOK * DM || ws_size < WS_END) { fprintf(stderr, "kernel_launch: unexpected shapes (n_in %d, out %d, ws %zu)\n", n_in, out_size, ws_size); grid = -1; return; }
        int dev = 0, cus = 0, per_cu = 0;
        if (hipGetDevice(&dev) != hipSuccess || hipDeviceGetAttribute(&cus, hipDeviceAttributeMultiprocessorCount, dev) != hipSuccess) { grid = -1; return; }
        if (hipFuncSetAttribute((const void*)fwd_kernel, hipFuncAttributeMaxDynamicSharedMemorySize, LDS_BYTES) != hipSuccess) { grid = -1; return; }
        if (hipOccupancyMaxActiveBlocksPerMultiprocessor(&per_cu, (const void*)fwd_kernel, 512, LDS_BYTES) != hipSuccess || per_cu < 1) per_cu = 1;
        (void)hipGetLastError();
        grid = cus * per_cu;
        if (grid != 256) { fprintf(stderr, "kernel_launch: this kernel's work split is built for a 256-workgroup grid (256 CUs x 1); got %d; nothing launched\n", grid); grid = -1; return; }
    }
    if (grid < 0) return;
    Args a{};
    a.x_prompt = (const float*)d_in[0]; a.x_sample = (const float*)d_in[1]; a.norm_g = (const float*)d_in[2]; a.w_in = (const float*)d_in[3];
    a.w_oa = (const float*)d_in[4]; a.w_ob = (const float*)d_in[5]; a.w_oc = (const float*)d_in[6]; a.w_out = (const float*)d_in[7];
    a.b_sink = (const float*)d_in[8]; a.lam_q1 = (const float*)d_in[9]; a.lam_k1 = (const float*)d_in[10]; a.lam_q2 = (const float*)d_in[11]; a.lam_k2 = (const float*)d_in[12];
    a.c_subln_g = (const float*)d_in[13]; a.final_norm_g = (const float*)d_in[14];
    a.out = (float*)d_out; a.ws = (unsigned char*)d_ws;
    if (hipMemsetAsync((char*)d_ws + WS_BAR, 0, 16384, stream) != hipSuccess) { fprintf(stderr, "memset failed\n"); return; }
    void* args[] = {&a};
    hipError_t e = hipLaunchCooperativeKernel((void*)fwd_kernel, dim3(grid), dim3(512), args, LDS_BYTES, stream);
    if (e != hipSuccess) fprintf(stderr, "cooperative launch failed: %s (grid %d)\n", hipGetErrorString(e), grid);
}
```

```cpp
#include <hip/hip_runtime.h>
#include <hip/hip_cooperative_groups.h>
#include <cstdio>
#include <cstdint>
namespace cg = cooperative_groups;

constexpr int DM = 1024, DIN = 11520, NTOK = 49152, MC = 16384, NCHUNK = 3, DEPTH = 4;
constexpr int QA = 0, KA = 1536, VA = 3072, GA = 4608, QB = 5120, KB = 5632, VB = 5760, GB = 5888, QC = 6400, KC = 6912, VC = 7424, GC = 7936, GM = 8448;
constexpr float RMS_EPS = 1e-6f, LOG2E = 1.4426950408889634f, QSCALE = 0.125f * 1.4426950408889634f;
constexpr size_t MiB = 1u << 20;
constexpr size_t WS_ROWSS = 0;
constexpr size_t WS_BAR = 512 * 1024;
constexpr int MISC_BASE = 139264, MISC_OFF = MISC_BASE + 320;
constexpr size_t WS_WIN = 1 * MiB;
constexpr size_t WS_WO3 = 91 * MiB;
constexpr size_t WS_WOUT = 103 * MiB;
constexpr size_t WS_XB = 111 * MiB;
constexpr size_t WS_P = 207 * MiB;
constexpr size_t WS_ACT = 567 * MiB;
constexpr size_t WS_MIX = 615 * MiB;
constexpr size_t WS_END = 647 * MiB;
constexpr int LDS_BYTES = 147456;
#define PB(col) ((size_t)((col) >> 6) * MC * 64 + ((col) & 63))

namespace pg8 {
#define PG8_LAS __attribute__((address_space(3)))
typedef unsigned short bf16_t;
typedef short bf16x8 __attribute__((ext_vector_type(8)));
typedef float f32x4 __attribute__((ext_vector_type(4)));
typedef unsigned u32x4 __attribute__((ext_vector_type(4)));
constexpr int BM = 256, BK = 64, HALF = 128, HTB = HALF * BK * 2  , STAGE_BYTES = 8 * HTB, NXCD = 8, WGM = 4;

__host__ __device__ __forceinline__ int lds_byte(int r, int c) { const int st = (r >> 4) * 2 + (c >> 5), rr = r & 15, cc = c & 31, ob = rr * 64 + cc * 2; return st * 1024 + (ob ^ (((ob >> 9) & 1) << 5)); }
__host__ __device__ __forceinline__ void stage_rc(int b, int& R, int& C) { const int st = b / 1024, sb = b % 1024, swz = sb ^ (((sb >> 9) & 1) << 5); R = (st >> 1) * 16 + swz / 64; C = (st & 1) * 32 + (swz % 64) / 2; }
__host__ __device__ __forceinline__ int perm32(int rho) { const int n = rho >> 4, i = rho & 15; return 8 * (i >> 2) + 4 * n + (i & 3); }

struct Unit { int pm, pn, br; };
struct Gemm { const bf16_t* A; const bf16_t* Bt; int M, N, K; size_t abr, bbr; };

struct OrderXcd {
    int nM, nN, nwg, G, c;
    __device__ void init(int M, int N, int G_, int c_) { nM = M / BM; nN = N / BM; nwg = nM * nN; G = G_; c = c_; }
    __device__ bool next(int i, Unit& u) const {
        const long L = (long)i * G + c; if (L >= nwg) return false;
        int wgid = (int)L; { const int q = nwg / NXCD, r = nwg % NXCD, xcd = wgid % NXCD, off = wgid / NXCD; wgid = (xcd < r ? xcd * (q + 1) : r * (q + 1) + (xcd - r) * q) + off; }
        const int nig = WGM * nN, gid = wgid / nig, fm = gid * WGM, gsz = (nM - fm) < WGM ? (nM - fm) : WGM;
        u.pm = fm + ((wgid % nig) % gsz); u.pn = (wgid % nig) / gsz; u.br = 0; return true;
    }
};
__device__ __forceinline__ void xcd_tile(int tl, int nN, int ntile, Unit& u) { if (nN == 4 && ntile == 256) { const int x = tl & 7, k = tl >> 3; u.pm = 8 * x + (k >> 2); u.pn = k & 3; } else { u.pm = tl / nN; u.pn = tl % nN; } }
struct OrderMix { int nN, ntile, G, c;
    __device__ bool next(int i, Unit& u) const { const int j = i / 3; const int tl = j * G + c; if (tl >= ntile) return false; xcd_tile(tl, nN, ntile, u); u.br = i - 3 * j; return true; } };
struct OrderFixed { int pm, pn; bool on;
    __device__ bool next(int i, Unit& u) const { if (i > 0 || !on) return false; u.pm = pm; u.pn = pn; u.br = 0; return true; } };
struct OrderOne { int nN, ntile, G, c;
    __device__ bool next(int i, Unit& u) const { const int tl = i * G + c; if (tl >= ntile) return false; xcd_tile(tl, nN, ntile, u); u.br = 0; return true; } };

__device__ __forceinline__ unsigned cvt_pk_bf16(float lo, float hi) { unsigned r; asm volatile("v_cvt_pk_bf16_f32 %0, %1, %2" : "=v"(r) : "v"(lo), "v"(hi)); return r; }
__device__ __forceinline__ float bf_lo(unsigned w) { return __uint_as_float(w << 16); }
__device__ __forceinline__ float bf_hi(unsigned w) { return __uint_as_float(w & 0xffff0000u); }
__device__ __forceinline__ float sigmoidf_(float x) { return __builtin_amdgcn_rcpf(1.0f + __builtin_amdgcn_exp2f(-x * 1.4426950408889634f)); }

struct EpiProj {
    static constexpr bool PERM = true;
    bf16_t* O; const float* rowss;
    __device__ __forceinline__ void operator()(const f32x4 (&acc)[2][2][4][2], const Unit& u, int wr, int wc, int fr, int fq) const {
        const int row0 = u.pm * BM + wr * 64 + fr, col0 = u.pn * BM + wc * 32 + 8 * fq, pn = u.pn;
        const float sc = (pn < 6 || (pn >= 20 && pn < 22) || (pn >= 25 && pn < 27)) ? 0.125f * 1.4426950408889634f : 1.0f;
        float rsv[2][4];
#pragma unroll
        for (int ai = 0; ai < 2; ++ai)
#pragma unroll
            for (int m = 0; m < 4; ++m) rsv[ai][m] = rowss[row0 + ai * HALF + m * 16];
#pragma unroll
        for (int ai = 0; ai < 2; ++ai)
#pragma unroll
            for (int m = 0; m < 4; ++m) { const int row = row0 + ai * HALF + m * 16; const float rs = rsqrtf(rsv[ai][m] * (1.0f / 1024.0f) + 1e-6f) * sc;
#pragma unroll
                for (int bj = 0; bj < 2; ++bj) { const f32x4 v0 = acc[ai][bj][m][0] * rs, v1 = acc[ai][bj][m][1] * rs;
                    u32x4 w; w.x = cvt_pk_bf16(v0[0], v0[1]); w.y = cvt_pk_bf16(v0[2], v0[3]); w.z = cvt_pk_bf16(v1[0], v1[1]); w.w = cvt_pk_bf16(v1[2], v1[3]);
                    *(u32x4*)(O + PB(col0 + bj * HALF) + (size_t)row * 64) = w; } }
    }
};
struct EpiMix {
    static constexpr bool PERM = true;
    const bf16_t* P; bf16_t* MIX;
    __device__ __forceinline__ void operator()(const f32x4 (&acc)[2][2][4][2], const Unit& u, int wr, int wc, int fr, int fq) const {
        const int row0 = u.pm * BM + wr * 64 + fr, col0 = u.pn * BM + wc * 32 + 8 * fq, br = u.br;
#pragma unroll
        for (int ai = 0; ai < 2; ++ai) {
            u32x4 gv[4][2], pv[4][2];
#pragma unroll
            for (int m = 0; m < 4; ++m)
#pragma unroll
                for (int bj = 0; bj < 2; ++bj) { const int row = row0 + ai * HALF + m * 16, col = col0 + bj * HALF;
                    gv[m][bj] = *(const u32x4*)(P + PB(8448 + br * 1024 + col) + (size_t)row * 64);
                    if (br > 0) pv[m][bj] = *(const u32x4*)(MIX + (size_t)row * 1024 + col); else pv[m][bj] = (u32x4){0u, 0u, 0u, 0u}; }
            asm volatile("" ::: "memory");
#pragma unroll
            for (int m = 0; m < 4; ++m) { const int row = row0 + ai * HALF + m * 16;
#pragma unroll
                for (int bj = 0; bj < 2; ++bj) { const int col = col0 + bj * HALF;
                    const u32x4 g = gv[m][bj];
                    bf16_t* mp = MIX + (size_t)row * 1024 + col;
                    f32x4 v0 = acc[ai][bj][m][0], v1 = acc[ai][bj][m][1];
                    v0[0] *= sigmoidf_(bf_lo(g.x)); v0[1] *= sigmoidf_(bf_hi(g.x)); v0[2] *= sigmoidf_(bf_lo(g.y)); v0[3] *= sigmoidf_(bf_hi(g.y));
                    v1[0] *= sigmoidf_(bf_lo(g.z)); v1[1] *= sigmoidf_(bf_hi(g.z)); v1[2] *= sigmoidf_(bf_lo(g.w)); v1[3] *= sigmoidf_(bf_hi(g.w));
                    if (br > 0) { const u32x4 p = pv[m][bj];
                        v0[0] += bf_lo(p.x); v0[1] += bf_hi(p.x); v0[2] += bf_lo(p.y); v0[3] += bf_hi(p.y); v1[0] += bf_lo(p.z); v1[1] += bf_hi(p.z); v1[2] += bf_lo(p.w); v1[3] += bf_hi(p.w); }
                    u32x4 w; w.x = cvt_pk_bf16(v0[0], v0[1]); w.y = cvt_pk_bf16(v0[2], v0[3]); w.z = cvt_pk_bf16(v1[0], v1[1]); w.w = cvt_pk_bf16(v1[2], v1[3]);
                    *(u32x4*)mp = w; } }
            asm volatile("" ::: "memory");
        }
    }
};
struct EpiOut {
    static constexpr bool PERM = true;
    const float* base; float* out; bf16_t* xb; float* rowss_next;
    __device__ __forceinline__ void operator()(const f32x4 (&acc)[2][2][4][2], const Unit& u, int wr, int wc, int fr, int fq) const {
        const int row0 = u.pm * BM + wr * 64 + fr, col0 = u.pn * BM + wc * 32 + 8 * fq;
#pragma unroll
        for (int ai = 0; ai < 2; ++ai)
#pragma unroll
            for (int mh = 0; mh < 2; ++mh) {
                f32x4 bv[2][2][2];
#pragma unroll
                for (int ml = 0; ml < 2; ++ml)
#pragma unroll
                    for (int bj = 0; bj < 2; ++bj) { const size_t off = (size_t)(row0 + ai * HALF + (2 * mh + ml) * 16) * 1024 + col0 + bj * HALF;
                        bv[ml][bj][0] = *(const f32x4*)(base + off); bv[ml][bj][1] = *(const f32x4*)(base + off + 4); }
                asm volatile("" ::: "memory");
#pragma unroll
                for (int ml = 0; ml < 2; ++ml) { const int m = 2 * mh + ml; const int row = row0 + ai * HALF + m * 16; float s = 0.f;
#pragma unroll
                    for (int bj = 0; bj < 2; ++bj) { const size_t off = (size_t)row * 1024 + col0 + bj * HALF;
                        const f32x4 v0 = bv[ml][bj][0] + acc[ai][bj][m][0], v1 = bv[ml][bj][1] + acc[ai][bj][m][1];
                        *(f32x4*)(out + off) = v0; *(f32x4*)(out + off + 4) = v1;
                        u32x4 w; w.x = cvt_pk_bf16(v0[0], v0[1]); w.y = cvt_pk_bf16(v0[2], v0[3]); w.z = cvt_pk_bf16(v1[0], v1[1]); w.w = cvt_pk_bf16(v1[2], v1[3]);
                        *(u32x4*)(xb + off) = w;
                        s += (v0[0] * v0[0] + v0[1] * v0[1]) + (v0[2] * v0[2] + v0[3] * v0[3]) + (v1[0] * v1[0] + v1[1] * v1[1]) + (v1[2] * v1[2] + v1[3] * v1[3]); }
                    s += __shfl_xor(s, 16); s += __shfl_xor(s, 32);
                    if (fq == 0) atomicAdd(rowss_next + row, s); }
                asm volatile("" ::: "memory");
            }
    }
};

template <class Epi, class Sched, bool ALIGN_EPI = false, bool SP2 = false>
__device__ __forceinline__ void gemm_phase(PG8_LAS unsigned char* lds, const Gemm g, const Sched& S, const Epi& E) {
    int tid = threadIdx.x; asm volatile("" : "+v"(tid));
    const int wid = __builtin_amdgcn_readfirstlane(tid >> 6), lane = tid & 63, wr = wid >> 2, wc = wid & 3, fr = lane & 15, fq = lane >> 4;
    const int K = g.K, nt = K / BK;
    unsigned voffA[2], voffB[2];
#pragma unroll
    for (int i = 0; i < 2; ++i) { int R, C; stage_rc(tid * 16 + i * 8192, R, C); const int Rb = Epi::PERM ? ((R & ~31) + perm32(R & 31)) : R;
        voffA[i] = (unsigned)(R * K + C) * 2u; voffB[i] = (unsigned)(Rb * K + C) * 2u; }
    const size_t kstep = (size_t)(BK * 2);
    const size_t hstep = (size_t)HALF * K * 2;
    const size_t tstep = 2 * hstep;
    const unsigned ldsw = (unsigned)wid * 1024u;
    const int aoff = lds_byte(wr * 64 + fr, fq * 8), boff = lds_byte(wc * 32 + fr, fq * 8);
#define PG8_SA(b, h) (((b) * 2 + (h)) * HTB)
#define PG8_SB(b, h) ((4 + (b) * 2 + (h)) * HTB)
#define PG8_STAGE(bufoff, gbase, voff) do { _Pragma("unroll") for (int _i = 0; _i < 2; ++_i) \
        __builtin_amdgcn_global_load_lds((const unsigned*)((const char*)(gbase) + (voff)[_i]), (PG8_LAS unsigned*)(lds + (bufoff) + ldsw + _i * 8192), 16, 0, 0); } while (0)
#define PG8_LDA(dst, b, h) do { _Pragma("unroll") for (int m = 0; m < 4; ++m) _Pragma("unroll") for (int k = 0; k < 2; ++k) dst[m][k] = *(const PG8_LAS bf16x8*)(lds + PG8_SA(b, h) + aoff + m * 2048 + k * 1024); } while (0)
#define PG8_LDB(dst, b, h) do { _Pragma("unroll") for (int n = 0; n < 2; ++n) _Pragma("unroll") for (int k = 0; k < 2; ++k) dst[n][k] = *(const PG8_LAS bf16x8*)(lds + PG8_SB(b, h) + boff + n * 2048 + k * 1024); } while (0)
#define PG8_MMA(ai, bj, At, Bt) do { __builtin_amdgcn_s_setprio(1); _Pragma("unroll") for (int m = 0; m < 4; ++m) _Pragma("unroll") for (int n = 0; n < 2; ++n) _Pragma("unroll") for (int k = 0; k < 2; ++k) \
        acc[ai][bj][m][n] = __builtin_amdgcn_mfma_f32_16x16x32_bf16(Bt[n][k], At[m][k], acc[ai][bj][m][n], 0, 0, 0); __builtin_amdgcn_s_setprio(0); } while (0)
#define PG8_WAIT_V(n) asm volatile("s_waitcnt vmcnt(" #n ")" ::: "memory")
#define PG8_WAIT_L(n) asm volatile("s_waitcnt lgkmcnt(" #n ")" ::: "memory")
#define PG8_BAR __builtin_amdgcn_s_barrier()
#define PG8_SCHED __builtin_amdgcn_sched_barrier(0)
    Unit cur, nxt; int ui = 0;
    if (!S.next(0, cur)) return;
    f32x4 acc[2][2][4][2];
#pragma unroll
    for (int a = 0; a < 2; ++a)
#pragma unroll
        for (int b = 0; b < 2; ++b)
#pragma unroll
            for (int m = 0; m < 4; ++m)
#pragma unroll
                for (int n = 0; n < 2; ++n) acc[a][b][m][n] = (f32x4){0.f, 0.f, 0.f, 0.f};
    bf16x8 At[4][2], B0[2][2], B1[2][2];
    const char* cA = (const char*)g.A + (size_t)cur.br * g.abr + (size_t)cur.pm * tstep; const char* cB = (const char*)g.Bt + (size_t)cur.br * g.bbr + (size_t)cur.pn * tstep;

    if constexpr (SP2) {
        PG8_STAGE(PG8_SB(0, 0), cB, voffB); PG8_STAGE(PG8_SB(0, 1), cB + hstep, voffB); PG8_STAGE(PG8_SA(0, 0), cA, voffA); PG8_STAGE(PG8_SA(0, 1), cA + hstep, voffA);
        if (wr == 1) PG8_BAR;
        PG8_WAIT_V(2); PG8_BAR;
        PG8_STAGE(PG8_SB(1, 0), cB + kstep, voffB); PG8_STAGE(PG8_SA(1, 0), cA + kstep, voffA); PG8_STAGE(PG8_SB(1, 1), cB + hstep + kstep, voffB);
        PG8_WAIT_V(6); PG8_BAR;
    } else {
        PG8_STAGE(PG8_SB(0, 0), cB, voffB); PG8_STAGE(PG8_SA(0, 0), cA, voffA); PG8_STAGE(PG8_SB(0, 1), cB + hstep, voffB); PG8_STAGE(PG8_SA(0, 1), cA + hstep, voffA);
        if (wr == 1) PG8_BAR;
        PG8_WAIT_V(4); PG8_BAR;
        PG8_STAGE(PG8_SB(1, 0), cB + kstep, voffB); PG8_STAGE(PG8_SA(1, 0), cA + kstep, voffA); PG8_STAGE(PG8_SB(1, 1), cB + hstep + kstep, voffB);
        PG8_WAIT_V(6); PG8_BAR;
    }
    for (;;) {
        const bool has_next = S.next(ui + 1, nxt);
        const char* nA = has_next ? (const char*)g.A + (size_t)nxt.br * g.abr + (size_t)nxt.pm * tstep : cA; const char* nB = has_next ? (const char*)g.Bt + (size_t)nxt.br * g.bbr + (size_t)nxt.pn * tstep : cB;
        for (int t = 0; t < nt; t += 2) {
            const bool last = (t == nt - 2);
            const char* a1 = cA + (size_t)(t + 1) * kstep;
            const char* a2 = last ? nA : cA + (size_t)(t + 2) * kstep; const char* b2 = last ? nB : cB + (size_t)(t + 2) * kstep;
            const char* a3 = a2 + kstep; const char* b3 = b2 + kstep;

            if constexpr (SP2) {
            PG8_LDB(B0, 0, 0); PG8_LDB(B1, 0, 1); PG8_SCHED; PG8_LDA(At, 0, 0); PG8_STAGE(PG8_SA(1, 1), a1 + hstep, voffA);
            PG8_WAIT_V(8); PG8_WAIT_L(0); PG8_BAR; PG8_MMA(0, 0, At, B0); PG8_MMA(0, 1, At, B1); PG8_BAR; PG8_SCHED;
            PG8_LDA(At, 0, 1); PG8_STAGE(PG8_SB(0, 0), b2, voffB); PG8_STAGE(PG8_SB(0, 1), b2 + hstep, voffB); PG8_STAGE(PG8_SA(0, 0), a2, voffA);
            PG8_WAIT_V(8); PG8_WAIT_L(0); PG8_BAR; PG8_MMA(1, 0, At, B0); PG8_MMA(1, 1, At, B1); PG8_BAR; PG8_SCHED;
            PG8_LDB(B0, 1, 0); PG8_LDB(B1, 1, 1); PG8_SCHED; PG8_LDA(At, 1, 0); PG8_STAGE(PG8_SA(0, 1), a2 + hstep, voffA);
            PG8_WAIT_V(8); PG8_WAIT_L(0); PG8_BAR; PG8_MMA(0, 0, At, B0); PG8_MMA(0, 1, At, B1); PG8_BAR; PG8_SCHED;
            PG8_LDA(At, 1, 1); PG8_STAGE(PG8_SB(1, 0), b3, voffB); PG8_STAGE(PG8_SB(1, 1), b3 + hstep, voffB); PG8_STAGE(PG8_SA(1, 0), a3, voffA);
            PG8_WAIT_V(8); PG8_WAIT_L(0); PG8_BAR; PG8_MMA(1, 0, At, B0); PG8_MMA(1, 1, At, B1); PG8_BAR; PG8_SCHED;
            } else {
            PG8_LDB(B0, 0, 0); PG8_SCHED; PG8_LDA(At, 0, 0); PG8_STAGE(PG8_SA(1, 1), a1 + hstep, voffA);
            PG8_WAIT_L(8); PG8_BAR; PG8_WAIT_L(0); PG8_MMA(0, 0, At, B0); PG8_BAR; PG8_SCHED;
            PG8_LDB(B1, 0, 1); PG8_STAGE(PG8_SB(0, 0), b2, voffB);
            PG8_BAR; PG8_WAIT_L(0); PG8_MMA(0, 1, At, B1); PG8_BAR;
            PG8_LDA(At, 0, 1); PG8_STAGE(PG8_SA(0, 0), a2, voffA);
            PG8_BAR; PG8_WAIT_L(0); PG8_MMA(1, 0, At, B0); PG8_BAR; PG8_SCHED;
            PG8_STAGE(PG8_SB(0, 1), b2 + hstep, voffB);
            PG8_WAIT_V(6); PG8_BAR; PG8_MMA(1, 1, At, B1); PG8_BAR;
            PG8_LDB(B0, 1, 0); PG8_SCHED; PG8_LDA(At, 1, 0); PG8_STAGE(PG8_SA(0, 1), a2 + hstep, voffA);
            PG8_WAIT_L(8); PG8_BAR; PG8_WAIT_L(0); PG8_MMA(0, 0, At, B0); PG8_BAR; PG8_SCHED;
            PG8_LDB(B1, 1, 1); PG8_STAGE(PG8_SB(1, 0), b3, voffB);
            PG8_BAR; PG8_WAIT_L(0); PG8_MMA(0, 1, At, B1); PG8_BAR;
            PG8_LDA(At, 1, 1); PG8_STAGE(PG8_SA(1, 0), a3, voffA);
            PG8_BAR; PG8_WAIT_L(0); PG8_MMA(1, 0, At, B0); PG8_BAR; PG8_SCHED;
            PG8_STAGE(PG8_SB(1, 1), b3 + hstep, voffB);
            PG8_WAIT_V(6); PG8_BAR; PG8_MMA(1, 1, At, B1); PG8_BAR;
            }
        }
        if constexpr (ALIGN_EPI) { if (wr == 0) PG8_BAR; }
        E(acc, cur, wr, wc, fr, fq);
        if (!has_next) break;
#pragma unroll
        for (int a = 0; a < 2; ++a)
#pragma unroll
            for (int b = 0; b < 2; ++b)
#pragma unroll
                for (int m = 0; m < 4; ++m)
#pragma unroll
                    for (int n = 0; n < 2; ++n) acc[a][b][m][n] = (f32x4){0.f, 0.f, 0.f, 0.f};
        cur = nxt; cA = nA; cB = nB; ++ui;
        if constexpr (ALIGN_EPI) { if (wr == 1) PG8_BAR; }
    }
    PG8_WAIT_V(0);
    if constexpr (!ALIGN_EPI) { if (wr == 0) PG8_BAR; }
    PG8_BAR;

#undef PG8_SA
#undef PG8_SB
#undef PG8_STAGE
#undef PG8_LDA
#undef PG8_LDB
#undef PG8_MMA
#undef PG8_WAIT_V
#undef PG8_WAIT_L
#undef PG8_BAR
#undef PG8_SCHED
}
}

#define LAS __attribute__((address_space(3)))
typedef unsigned short bf16_t;
typedef short bf16x8 __attribute__((ext_vector_type(8)));
typedef short s16x4 __attribute__((ext_vector_type(4)));
typedef float f32x4 __attribute__((ext_vector_type(4)));
typedef float f32x2 __attribute__((ext_vector_type(2)));
typedef float f32x16 __attribute__((ext_vector_type(16)));
typedef unsigned u32x4 __attribute__((ext_vector_type(4)));
typedef unsigned u32x2 __attribute__((ext_vector_type(2)));
typedef __bf16 bf16x2_t __attribute__((ext_vector_type(2)));
typedef short v4i16_t __attribute__((ext_vector_type(4)));

__device__ __forceinline__ unsigned cvtpk(float lo, float hi) { f32x2 v = {lo, hi}; bf16x2_t b = __builtin_convertvector(v, bf16x2_t); return __builtin_bit_cast(unsigned, b); }
__device__ __forceinline__ float bflo(unsigned w) { return __uint_as_float(w << 16); }
__device__ __forceinline__ float bfhi(unsigned w) { return __uint_as_float(w & 0xffff0000u); }
__device__ __forceinline__ float silu_(float x) { return x * __builtin_amdgcn_rcpf(1.0f + __builtin_amdgcn_exp2f(-x * LOG2E)); }
__device__ __forceinline__ float wave_sum(float v) {
#pragma unroll
    for (int o = 1; o < 64; o <<= 1) v += __shfl_xor(v, o);
    return v;
}

__device__ __forceinline__ void transpose_item(const float* W, int K, int N, bf16_t* WT, const float* g, LAS float* scr, int item, int lane) {
    const int nblk = N / 32, kb = item / nblk, nb = item % nblk, k0 = 64 * kb, n0 = 32 * nb;
    float wv[32], gl[32];
#pragma unroll
    for (int i = 0; i < 32; ++i) { const int kk = 2 * i + (lane >> 5); wv[i] = W[(size_t)(k0 + kk) * N + n0 + (lane & 31)]; gl[i] = g ? g[k0 + kk] : 1.0f; }
#pragma unroll
    for (int i = 0; i < 32; ++i) { const int kk = 2 * i + (lane >> 5); scr[kk * 33 + (lane & 31)] = wv[i] * gl[i]; }
    asm volatile("s_waitcnt lgkmcnt(0)" ::: "memory");
    const int c = lane & 7;
#pragma unroll
    for (int j = 0; j < 4; ++j) { const int n = (lane >> 3) + 8 * j; const LAS float* s = scr + (8 * c) * 33 + n;
        u32x4 o; o.x = cvtpk(s[0 * 33], s[1 * 33]); o.y = cvtpk(s[2 * 33], s[3 * 33]); o.z = cvtpk(s[4 * 33], s[5 * 33]); o.w = cvtpk(s[6 * 33], s[7 * 33]);
        *(u32x4*)(WT + (size_t)(n0 + n) * K + k0 + 8 * c) = o; }
    asm volatile("s_waitcnt lgkmcnt(0)" ::: "memory");
}
__device__ __forceinline__ void row_to_bf16(const float* xrow, bf16_t* orow, float* ss, int lane) {
    const f32x4* xr = (const f32x4*)xrow + lane; float s = 0.f;
    u32x2* o8 = (u32x2*)orow + lane;
    f32x4 vv[4];
#pragma unroll
    for (int j = 0; j < 4; ++j) vv[j] = xr[64 * j];
#pragma unroll
    for (int j = 0; j < 4; ++j) { const f32x4 v = vv[j]; s += (v.x * v.x + v.y * v.y) + (v.z * v.z + v.w * v.w); u32x2 w; w.x = cvtpk(v.x, v.y); w.y = cvtpk(v.z, v.w); o8[64 * j] = w; }
    s = wave_sum(s);
    if (lane == 0) *ss = s;
}
__device__ __forceinline__ void final_norm_row(float* xrow, const float* ss, const float* g, int lane) {
    f32x4* xr = (f32x4*)xrow + lane; const f32x4* gr = (const f32x4*)g + lane;
    const float rs = rsqrtf(*ss * (1.0f / 1024.0f) + RMS_EPS);
    f32x4 vv[4], gv[4];
#pragma unroll
    for (int j = 0; j < 4; ++j) { vv[j] = xr[64 * j]; gv[j] = gr[64 * j]; }
#pragma unroll
    for (int j = 0; j < 4; ++j) xr[64 * j] = vv[j] * rs * gv[j];
}

__device__ __forceinline__ s16x4 vtr(const LAS char* p) { return __builtin_bit_cast(s16x4, __builtin_amdgcn_ds_read_tr16_b64_v4i16((LAS v4i16_t*)p)); }

template <int NDB, int NKG>
__device__ __forceinline__ void softmax_pv(f32x16& s, float& m, float& l, f32x16 (&o)[NDB], const LAS char* vtile, int kg0, int troff) {
    float rm = fmaxf(s[0], s[1]);
#pragma unroll
    for (int r = 2; r < 16; ++r) rm = fmaxf(rm, s[r]);
    rm = fmaxf(rm, __shfl_xor(rm, 32));
    const float mn = fmaxf(m, rm);
    if (__any(rm > m + 8.0f)) {
        const float alpha = __builtin_amdgcn_exp2f(m - mn);
        l *= alpha;
#pragma unroll
        for (int db = 0; db < NDB; ++db) o[db] = o[db] * alpha;
        m = mn;
    }
    float ps = 0.f;
#pragma unroll
    for (int r = 0; r < 16; ++r) { s[r] = __builtin_amdgcn_exp2f(s[r] - m); ps += s[r]; }
    l += ps;
    bf16x8 pf[2];
#pragma unroll
    for (int st = 0; st < 2; ++st) { u32x4 w; w.x = cvtpk(s[8 * st + 0], s[8 * st + 1]); w.y = cvtpk(s[8 * st + 2], s[8 * st + 3]); w.z = cvtpk(s[8 * st + 4], s[8 * st + 5]); w.w = cvtpk(s[8 * st + 6], s[8 * st + 7]); pf[st] = __builtin_bit_cast(bf16x8, w); }
    s16x4 vlo[NDB][2], vhi[NDB][2];
#pragma unroll
    for (int db = 0; db < NDB; ++db)
#pragma unroll
        for (int st = 0; st < 2; ++st) { const LAS char* p = vtile + (db * NKG + kg0 + st) * 1024 + troff; vlo[db][st] = vtr(p); vhi[db][st] = vtr(p + 512); }
    __builtin_amdgcn_sched_barrier(0);
#pragma unroll
    for (int st = 0; st < 2; ++st)
#pragma unroll
        for (int db = 0; db < NDB; ++db) {
            const bf16x8 vf = {vlo[db][st][0], vlo[db][st][1], vlo[db][st][2], vlo[db][st][3], vhi[db][st][0], vhi[db][st][1], vhi[db][st][2], vhi[db][st][3]};
            o[db] = __builtin_amdgcn_mfma_f32_32x32x16_bf16(vf, pf[st], o[db], 0, 0, 0);
        }
}

struct WSeg { const bf16_t* q; size_t qstride; const bf16_t* k; const bf16_t* v; size_t kstride; int qsub0, qstep, L, W; float nslope2; };
__device__ __forceinline__ void wave_banded(const WSeg& g, LAS char* vl, float& m, float& l, f32x16 (&o)[2], int lane) {
    const int r = lane & 31, hh = lane >> 5;
    bf16x8 qf[4];
    { const bf16_t* qp = g.q + (size_t)r * g.qstride + 8 * hh;
#pragma unroll
      for (int ks = 0; ks < 4; ++ks) qf[ks] = *(const bf16x8*)(qp + 16 * ks); }
    const int qsub = g.qsub0 + r * g.qstep;
    int lo = g.qsub0 - g.W; if (lo < 0) lo = 0;
    int hi = g.qsub0 + 31 * g.qstep + g.W; if (hi > g.L - 1) hi = g.L - 1;
    const int kt_lo = lo >> 5, kt_hi = hi >> 5;
    const int vrow = lane >> 3, vc8 = lane & 7;
    const int vwoff = ((vc8 >> 2) * 2) * 1024 + (vc8 & 3) * 16;
    const int troff = (4 * hh + ((lane & 15) >> 2)) * 64 + (((lane >> 4) & 1) * 16 + (lane & 3) * 4) * 2;
    const float wf = (float)g.W;
    LAS char* kl = vl + 4096;
    u32x4 ka[4], va[4], kb[4], vb[4];
#define WB_LOAD(KR, VR, KT) do { const int k0_ = (KT) * 32; \
        _Pragma("unroll") for (int i = 0; i < 4; ++i) { const size_t ro_ = (size_t)(k0_ + vrow + 8 * i) * g.kstride + vc8 * 8; KR[i] = *(const u32x4*)(g.k + ro_); VR[i] = *(const u32x4*)(g.v + ro_); } } while (0)
#define WB_STEP(KR, VR, KT) do { \
        asm volatile("" ::: "memory"); \
        _Pragma("unroll") for (int i = 0; i < 4; ++i) { const int row = vrow + 8 * i; *(LAS u32x4*)(vl + vwoff + (row >> 4) * 1024 + (row & 15) * 64) = VR[i]; *(LAS u32x4*)(kl + vc8 * 528 + row * 16) = KR[i]; } \
        asm volatile("" ::: "memory"); \
        bf16x8 kf[4]; \
        _Pragma("unroll") for (int ks = 0; ks < 4; ++ks) kf[ks] = *(const LAS bf16x8*)(kl + (2 * ks + hh) * 528 + r * 16); \
        f32x16 s = {0.f, 0.f, 0.f, 0.f, 0.f, 0.f, 0.f, 0.f, 0.f, 0.f, 0.f, 0.f, 0.f, 0.f, 0.f, 0.f}; \
        _Pragma("unroll") for (int ks = 0; ks < 4; ++ks) s = __builtin_amdgcn_mfma_f32_32x32x16_bf16(kf[ks], qf[ks], s, 0, 0, 0); \
        const float dq = (float)(qsub - (KT) * 32 - 4 * hh); \
        _Pragma("unroll") for (int rg = 0; rg < 16; ++rg) { const float cr = (float)((rg & 3) + 8 * (rg >> 2)); const float d = fabsf(dq - cr); const float v = s[rg] + g.nslope2 * d; s[rg] = (d <= wf) ? v : -1e30f; } \
        softmax_pv<2, 2>(s, m, l, o, vl, 0, troff); \
        asm volatile("" ::: "memory"); } while (0)
    WB_LOAD(ka, va, kt_lo);
    if (kt_lo + 1 <= kt_hi) WB_LOAD(kb, vb, kt_lo + 1);
    for (int kt = kt_lo; kt <= kt_hi; kt += 2) {
        WB_STEP(ka, va, kt);
        if (kt + 2 <= kt_hi) WB_LOAD(ka, va, kt + 2);
        if (kt + 1 <= kt_hi) {
            WB_STEP(kb, vb, kt + 1);
            if (kt + 3 <= kt_hi) WB_LOAD(kb, vb, kt + 3);
        }
    }
#undef WB_STEP
#undef WB_LOAD
}
__device__ __forceinline__ void wave_store64(const f32x16 (&o)[2], float l, const bf16_t* gate, bf16_t* dst, int lane) {
    const int hh = lane >> 5;
    u32x2 gw[2][4];
#pragma unroll
    for (int db = 0; db < 2; ++db)
#pragma unroll
        for (int g4 = 0; g4 < 4; ++g4) gw[db][g4] = *(const u32x2*)(gate + 32 * db + 8 * g4 + 4 * hh);
    l += __shfl_xor(l, 32);
    const float inv = 1.0f / l;
#pragma unroll
    for (int db = 0; db < 2; ++db)
#pragma unroll
        for (int g4 = 0; g4 < 4; ++g4) { const int dv = 32 * db + 8 * g4 + 4 * hh;
            u32x2 w; w.x = cvtpk(o[db][4 * g4 + 0] * inv * silu_(bflo(gw[db][g4].x)), o[db][4 * g4 + 1] * inv * silu_(bfhi(gw[db][g4].x)));
            w.y = cvtpk(o[db][4 * g4 + 2] * inv * silu_(bflo(gw[db][g4].y)), o[db][4 * g4 + 3] * inv * silu_(bfhi(gw[db][g4].y)));
            *(u32x2*)(dst + dv) = w; }
}
constexpr int WV_LDS = 8320, A_ACC = 8 * WV_LDS, A_TOKB = 136, A_LSE = A_ACC + 512 * A_TOKB;
__device__ __forceinline__ void attn_A_span(const bf16_t* P, bf16_t* act_a, int S, int seqbase, int tl0, int h, LAS char* lds, int wave, int lane) {
    LAS char* vl = lds + wave * WV_LDS;
    const int r = lane & 31, hh = lane >> 5;
#pragma unroll 1
    for (int g = 0; g < 3; ++g) {
        const int sh = 2 * g, dil = 1 << sh, gh = g * 8 + h;
        const float nslope2 = -exp2f(-(float)(gh + 1) * (1.0f / 3.0f)) * (float)dil * LOG2E;
#pragma unroll 1
        for (int rep = 0; rep < 2; ++rep) {
            const int it = wave + 8 * rep, rho = it & (dil - 1), j = it >> sh;
            float m = -30000.f, l = 0.f; f32x16 o[2];
#pragma unroll
            for (int i = 0; i < 16; ++i) { o[0][i] = 0.f; o[1][i] = 0.f; }
            WSeg sg;
            sg.q = P + PB(QA + gh * 64) + (size_t)(seqbase + tl0 + rho + dil * 32 * j) * 64; sg.qstride = (size_t)dil * 64;
            sg.k = P + PB(KA + gh * 64) + (size_t)(seqbase + rho) * 64; sg.v = P + PB(VA + gh * 64) + (size_t)(seqbase + rho) * 64; sg.kstride = (size_t)dil * 64;
            sg.qsub0 = (tl0 >> sh) + 32 * j; sg.qstep = 1; sg.L = S >> sh; sg.W = 64; sg.nslope2 = nslope2;
            wave_banded(sg, vl, m, l, o, lane);
            l += __shfl_xor(l, 32);
            const float inv = 1.0f / l;
            float lse = m + __builtin_amdgcn_logf(l);
            const int ti = rho + dil * (32 * j + r);
            LAS char* ap = lds + A_ACC + ti * A_TOKB + 8 * hh;
            LAS float* lp = (LAS float*)(lds + A_LSE) + ti;
            float wa = 0.f, wb = inv;
            if (g > 0) {
                const float lse_a = *lp; const float mx = fmaxf(lse_a, lse);
                const float ea = __builtin_amdgcn_exp2f(lse_a - mx), eb = __builtin_amdgcn_exp2f(lse - mx);
                const float den = 1.0f / (ea + eb);
                wa = ea * den; wb = eb * den * inv;
                lse = mx + __builtin_amdgcn_logf(ea + eb);
            }
            const int tok = seqbase + tl0 + ti;
            const bf16_t* gate = P + PB(GA + h * 64) + (size_t)tok * 64;
            bf16_t* dst = act_a + (size_t)tok * 512 + h * 64;
            u32x2 gwv[2][4];
            if (g == 2) {
#pragma unroll
                for (int db = 0; db < 2; ++db)
#pragma unroll
                    for (int g4 = 0; g4 < 4; ++g4) gwv[db][g4] = *(const u32x2*)(gate + 32 * db + 8 * g4 + 4 * hh);
            }
#pragma unroll
            for (int db = 0; db < 2; ++db)
#pragma unroll
                for (int g4 = 0; g4 < 4; ++g4) {
                    float v0 = o[db][4 * g4 + 0] * wb, v1 = o[db][4 * g4 + 1] * wb, v2 = o[db][4 * g4 + 2] * wb, v3 = o[db][4 * g4 + 3] * wb;
                    LAS u32x2* a2 = (LAS u32x2*)(ap + 64 * db + 16 * g4);
                    if (g > 0) { const u32x2 pa = *a2; v0 += wa * bflo(pa.x); v1 += wa * bfhi(pa.x); v2 += wa * bflo(pa.y); v3 += wa * bfhi(pa.y); }
                    if (g < 2) { u32x2 w; w.x = cvtpk(v0, v1); w.y = cvtpk(v2, v3); *a2 = w; }
                    else { const int dv = 32 * db + 8 * g4 + 4 * hh; const u32x2 gw = gwv[db][g4];
                        u32x2 w; w.x = cvtpk(v0 * silu_(bflo(gw.x)), v1 * silu_(bfhi(gw.x))); w.y = cvtpk(v2 * silu_(bflo(gw.y)), v3 * silu_(bfhi(gw.y))); *(u32x2*)(dst + dv) = w; }
                }
            if (g < 2 && hh == 0) *lp = lse;
        }
        __syncthreads();
    }
}
__device__ __forceinline__ void attn_B_wave(const bf16_t* P, bf16_t* act_b, int S, int seqbase, int t0, int hq, float sink, LAS char* vl, int lane) {
    float m = sink * LOG2E, l = (lane < 32) ? 1.0f : 0.0f; f32x16 o[2];
#pragma unroll
    for (int i = 0; i < 16; ++i) { o[0][i] = 0.f; o[1][i] = 0.f; }
    const int kvh = hq >> 2;
    WSeg sg;
    sg.q = P + PB(QB + hq * 64) + (size_t)(seqbase + t0) * 64; sg.qstride = (size_t)64;
    sg.k = P + PB(KB + kvh * 64) + (size_t)seqbase * 64; sg.v = P + PB(VB + kvh * 64) + (size_t)seqbase * 64; sg.kstride = (size_t)64;
    sg.qsub0 = t0; sg.qstep = 1; sg.L = S; sg.W = 128;
    sg.nslope2 = -exp2f(-(float)(hq + 1)) * LOG2E;
    wave_banded(sg, vl, m, l, o, lane);
    const int tok = seqbase + t0 + (lane & 31);
    wave_store64(o, l, P + PB(GB + hq * 64) + (size_t)tok * 64, act_b + (size_t)tok * 512 + hq * 64, lane);
}

constexpr int C_KCS = 1024, C_K2 = 8 * C_KCS, C_V = 2 * 8 * C_KCS, C_BUF = C_V + 16384;
__device__ __forceinline__ void attn_C_item(const bf16_t* P, bf16_t* act_c, int S, int seqbase, int q0, int h, float lam, float oml, const float* subln_g, LAS char* lds, int tid, int w, int lane) {
    const int map = w >> 2, qrow = q0 + 32 * (w & 3), r = lane & 31, hh = lane >> 5;
    bf16x8 qf[4];
    { const bf16_t* qp = P + PB(QC + (h * 2 + map) * 64) + (size_t)(seqbase + qrow + r) * 64 + 8 * hh;
#pragma unroll
      for (int ks = 0; ks < 4; ++ks) qf[ks] = *(const bf16x8*)(qp + 16 * ks); }
    const float nslope2 = -exp2f(-2.0f * (float)(h + 1)) * LOG2E;
    const int NT = S / 64;
    const bf16_t* k1src = P + PB(KC + (h * 2) * 64) + (size_t)(seqbase + 8 * w + (lane >> 3)) * 64 + (((lane & 7) ^ ((lane >> 3) & 7) ^ (w & 1)) * 8);
    const bf16_t* v0src = P + PB(VC + h * 128) + (size_t)(seqbase + (w & 3) * 16 + (lane >> 2)) * 64 + (w >> 2) * 32 + (lane & 3) * 8;
    (void)tid;
    const int troff = (4 * hh + ((lane & 15) >> 2)) * 64 + (((lane >> 4) & 1) * 16 + (lane & 3) * 4) * 2;
    const int kroff = map * C_K2 + r * 128, ksw = (r & 7) ^ ((r >> 3) & 1);
    float m = 0.f, l = 0.f; f32x16 o[4];
#pragma unroll
    for (int i = 0; i < 16; ++i) { o[0][i] = 0.f; o[1][i] = 0.f; o[2][i] = 0.f; o[3][i] = 0.f; }
    f32x16 negm;
#pragma unroll
    for (int i = 0; i < 16; ++i) negm[i] = 0.f;
#define C_GLDS(GSRC, LOFF) do { unsigned keep_; const unsigned ld_ = (unsigned)__builtin_amdgcn_readfirstlane((int)(lds0 + (unsigned)(LOFF))); \
        asm volatile("s_mov_b32 %0, m0\n\ts_mov_b32 m0, %2\n\ts_nop 0\n\tglobal_load_lds_dwordx4 %1, off\n\ts_mov_b32 m0, %0" : "=&s"(keep_) : "v"(GSRC), "s"(ld_) : "memory"); } while (0)
#define C_DMA(T, B) do { const size_t ro_ = (size_t)(T) * 64 * 64; const int d_ = (B) * C_BUF; \
        C_GLDS(k1src + ro_, d_ + w * C_KCS); C_GLDS(k1src + ro_ + (size_t)MC * 64, d_ + C_K2 + w * C_KCS); \
        C_GLDS(v0src + ro_, d_ + C_V + w * 1024); C_GLDS(v0src + ro_ + (size_t)MC * 64, d_ + C_V + (w + 8) * 1024); } while (0)
    const unsigned lds0 = (unsigned)(uintptr_t)lds;
    const int qpos = qrow + r;
    bf16x8 pf[4]; bool pvalid = false;
    auto pv = [&](const LAS char* buf) __attribute__((always_inline)) {
            if (pvalid) {
                const LAS char* vt = buf + C_V + troff;
                s16x4 vlo[2][4], vhi[2][4];
#define PV_RD(ST, SET) do { _Pragma("unroll") for (int db = 0; db < 4; ++db) { const LAS char* p = vt + (db * 4 + (ST)) * 1024; vlo[SET][db] = vtr(p); vhi[SET][db] = vtr(p + 512); } } while (0)
#define PV_MM(ST, SET) do { _Pragma("unroll") for (int db = 0; db < 4; ++db) { const bf16x8 vf = {vlo[SET][db][0], vlo[SET][db][1], vlo[SET][db][2], vlo[SET][db][3], vhi[SET][db][0], vhi[SET][db][1], vhi[SET][db][2], vhi[SET][db][3]}; \
                        o[db] = __builtin_amdgcn_mfma_f32_32x32x16_bf16(vf, pf[ST], o[db], 0, 0, 0); } } while (0)
                __builtin_amdgcn_s_setprio(1);
                PV_RD(0, 0); PV_RD(1, 1); __builtin_amdgcn_sched_barrier(0);
                PV_MM(0, 0); __builtin_amdgcn_sched_barrier(0);
                PV_RD(2, 0); __builtin_amdgcn_sched_barrier(0);
                PV_MM(1, 1); __builtin_amdgcn_sched_barrier(0);
                PV_RD(3, 1); __builtin_amdgcn_sched_barrier(0);
                PV_MM(2, 0); __builtin_amdgcn_sched_barrier(0);
                PV_MM(3, 1); __builtin_amdgcn_sched_barrier(0);
                __builtin_amdgcn_s_setprio(0);
#undef PV_RD
#undef PV_MM
            }
    };
    f32x16 s0, s1; float rm = 0.f;
    auto qk = [&](const LAS char* buf) __attribute__((always_inline)) {
            s0 = negm; s1 = negm;
            bf16x8 kfa[4], kfb[4];
#pragma unroll
            for (int ks = 0; ks < 4; ++ks) { const int co = ((2 * ks + hh) ^ ksw) << 4; kfa[ks] = *(const LAS bf16x8*)(buf + kroff + co); kfb[ks] = *(const LAS bf16x8*)(buf + kroff + co + 4096); }
            __builtin_amdgcn_sched_barrier(0);
            __builtin_amdgcn_s_setprio(1);
#pragma unroll
            for (int ks = 0; ks < 4; ++ks) {
                s0 = __builtin_amdgcn_mfma_f32_32x32x16_bf16(kfa[ks], qf[ks], s0, 0, 0, 0);
                s1 = __builtin_amdgcn_mfma_f32_32x32x16_bf16(kfb[ks], qf[ks], s1, 0, 0, 0);
            }
            __builtin_amdgcn_s_setprio(0);
            __builtin_amdgcn_sched_barrier(0);
    };
#define C_BIASMAX(T) do { const float dq_ = (float)(qpos - (T) * 64 - 4 * hh); \
            _Pragma("unroll") for (int rg = 0; rg < 16; ++rg) { const float cr = (float)((rg & 3) + 8 * (rg >> 2)); s0[rg] = s0[rg] + nslope2 * fabsf(dq_ - cr); s1[rg] = s1[rg] + nslope2 * fabsf(dq_ - (cr + 32.0f)); } \
            rm = fmaxf(fmaxf(s0[0], s0[1]), fmaxf(s1[0], s1[1])); \
            _Pragma("unroll") for (int rg = 2; rg < 16; ++rg) rm = fmaxf(rm, fmaxf(s0[rg], s1[rg])); } while (0)
    auto fin = [&](const bool first) __attribute__((always_inline)) {
            { auto rr = __builtin_amdgcn_permlane32_swap(__float_as_uint(rm), __float_as_uint(rm), false, false); rm = fmaxf(__uint_as_float(rr[0]), __uint_as_float(rr[1])); }
            pvalid = first || !__all(rm < -150.0f);
            if (pvalid) {
                if (first || __any(rm > 8.0f)) {
                    const float dl = first ? rm : fmaxf(rm, 0.0f); m += dl;
                    if (!first) { const float alpha = __builtin_amdgcn_exp2f(-dl); l *= alpha;
#pragma unroll
                    for (int db = 0; db < 4; ++db) o[db] = o[db] * alpha; }
#pragma unroll
                    for (int rg = 0; rg < 16; ++rg) { s0[rg] -= dl; s1[rg] -= dl; negm[rg] = -m; }
                }
                float ps0 = 0.f, ps1 = 0.f;
#pragma unroll
                for (int rg = 0; rg < 16; ++rg) { s0[rg] = __builtin_amdgcn_exp2f(s0[rg]); s1[rg] = __builtin_amdgcn_exp2f(s1[rg]); ps0 += s0[rg]; ps1 += s1[rg]; }
                l += ps0 + ps1;
#pragma unroll
                for (int st = 0; st < 2; ++st) {
                    u32x4 wa, wb;
                    wa.x = cvtpk(s0[8 * st + 0], s0[8 * st + 1]); wa.y = cvtpk(s0[8 * st + 2], s0[8 * st + 3]); wa.z = cvtpk(s0[8 * st + 4], s0[8 * st + 5]); wa.w = cvtpk(s0[8 * st + 6], s0[8 * st + 7]);
                    wb.x = cvtpk(s1[8 * st + 0], s1[8 * st + 1]); wb.y = cvtpk(s1[8 * st + 2], s1[8 * st + 3]); wb.z = cvtpk(s1[8 * st + 4], s1[8 * st + 5]); wb.w = cvtpk(s1[8 * st + 6], s1[8 * st + 7]);
                    pf[st] = __builtin_bit_cast(bf16x8, wa); pf[2 + st] = __builtin_bit_cast(bf16x8, wb);
                }
            }
    };
    auto pv_bm = [&](const LAS char* bufp, const int T) __attribute__((always_inline)) {
            const LAS char* vt = bufp + C_V + troff;
            s16x4 vlo[2][4], vhi[2][4];
#define PV_RD(ST, SET) do { _Pragma("unroll") for (int db = 0; db < 4; ++db) { const LAS char* p = vt + (db * 4 + (ST)) * 1024; vlo[SET][db] = vtr(p); vhi[SET][db] = vtr(p + 512); } } while (0)
#define PV_MM(ST, SET) do { _Pragma("unroll") for (int db = 0; db < 4; ++db) { const bf16x8 vf = {vlo[SET][db][0], vlo[SET][db][1], vlo[SET][db][2], vlo[SET][db][3], vhi[SET][db][0], vhi[SET][db][1], vhi[SET][db][2], vhi[SET][db][3]}; \
                        o[db] = __builtin_amdgcn_mfma_f32_32x32x16_bf16(vf, pf[ST], o[db], 0, 0, 0); } } while (0)
            __builtin_amdgcn_sched_barrier(0);
            PV_RD(0, 0); PV_RD(1, 1);
            C_BIASMAX(T);
            PV_MM(0, 0); PV_RD(2, 0); PV_MM(1, 1); PV_RD(3, 1); PV_MM(2, 0); PV_MM(3, 1);
            __builtin_amdgcn_sched_group_barrier(0x100, 16, 0);
#pragma unroll
            for (int i = 0; i < 4; ++i) { __builtin_amdgcn_sched_group_barrier(0x008, 1, 0); __builtin_amdgcn_sched_group_barrier(0x002, 6, 0); }
            __builtin_amdgcn_sched_group_barrier(0x100, 8, 0);
#pragma unroll
            for (int i = 0; i < 4; ++i) { __builtin_amdgcn_sched_group_barrier(0x008, 1, 0); __builtin_amdgcn_sched_group_barrier(0x002, 6, 0); }
            __builtin_amdgcn_sched_group_barrier(0x100, 8, 0);
#pragma unroll
            for (int i = 0; i < 8; ++i) { __builtin_amdgcn_sched_group_barrier(0x008, 1, 0); __builtin_amdgcn_sched_group_barrier(0x002, 6, 0); }
            __builtin_amdgcn_sched_barrier(0);
#undef PV_RD
#undef PV_MM
    };
    const int td = q0 >> 6;
#define TSEQ(I) (((I) < NT - td) ? td + (I) : NT - 1 - (I))
    C_DMA(TSEQ(0), 0); C_DMA(TSEQ(1), 1);
    for (int t = 0; t < NT; ++t) {
        if (t + 1 < NT) asm volatile("s_waitcnt vmcnt(4)\n\ts_barrier" ::: "memory"); else asm volatile("s_waitcnt vmcnt(0)\n\ts_barrier" ::: "memory");
        if (t + 2 < NT) C_DMA(TSEQ(t + 2), (t + 2) & 3);
        const int T = TSEQ(t);
        qk((const LAS char*)lds + (t & 3) * C_BUF);
        if (t > 0 && pvalid) pv_bm((const LAS char*)lds + ((t - 1) & 3) * C_BUF, T); else C_BIASMAX(T);
        fin(t == 0);
    }
    pv((const LAS char*)lds + ((NT - 1) & 3) * C_BUF);
#undef C_BIASMAX
    asm volatile("s_waitcnt vmcnt(0) lgkmcnt(0)\n\ts_barrier" ::: "memory");
#undef C_DMA
#undef TSEQ
#undef C_GLDS
    l += __shfl_xor(l, 32);
    const float inv = 1.0f / l;
    LAS float* xch = (LAS float*)lds + (size_t)(w & 3) * 4096 + lane;
    if (map == 1) {
#pragma unroll
        for (int db = 0; db < 4; ++db)
#pragma unroll
            for (int i = 0; i < 16; ++i) xch[(db * 16 + i) * 64] = o[db][i] * inv;
    }
    __syncthreads();
    if (map == 0) {
        float ss = 0.f;
#pragma unroll
        for (int db = 0; db < 4; ++db)
#pragma unroll
            for (int i = 0; i < 16; ++i) { const float d = o[db][i] * inv - lam * xch[(db * 16 + i) * 64]; o[db][i] = d; ss += d * d; }
        ss += __shfl_xor(ss, 32);
        const float rn = rsqrtf(ss * (1.0f / 128.0f) + RMS_EPS) * oml;
        const int tok = seqbase + qrow + r;
        const bf16_t* gate = P + PB(GC + h * 128) + (size_t)tok * 64;
        bf16_t* dst = act_c + (size_t)tok * 512 + h * 128;
#pragma unroll
        for (int dh = 0; dh < 2; ++dh) {
        u32x2 gwv[2][4]; f32x4 sgv[2][4];
#pragma unroll
        for (int db = 0; db < 2; ++db)
#pragma unroll
            for (int g4 = 0; g4 < 4; ++g4) { gwv[db][g4] = *(const u32x2*)(gate + (size_t)dh * MC * 64 + 32 * db + 8 * g4 + 4 * hh); sgv[db][g4] = *(const f32x4*)(subln_g + 32 * (2 * dh + db) + 8 * g4 + 4 * hh); }
        asm volatile("" ::: "memory");
#pragma unroll
        for (int dbl = 0; dbl < 2; ++dbl)
#pragma unroll
            for (int g4 = 0; g4 < 4; ++g4) { const int db = 2 * dh + dbl; const int dv = 32 * db + 8 * g4 + 4 * hh;
                const u32x2 gw = gwv[dbl][g4]; const f32x4 sg = sgv[dbl][g4];
                u32x2 wv; wv.x = cvtpk(o[db][4 * g4 + 0] * rn * sg.x * silu_(bflo(gw.x)), o[db][4 * g4 + 1] * rn * sg.y * silu_(bfhi(gw.x)));
                wv.y = cvtpk(o[db][4 * g4 + 2] * rn * sg.z * silu_(bflo(gw.y)), o[db][4 * g4 + 3] * rn * sg.w * silu_(bfhi(gw.y)));
                *(u32x2*)(dst + dv) = wv; }
        asm volatile("" ::: "memory");
        }
    }
    __syncthreads();
}

#define XB_TMO      128
#define XB_XCNT(j)  (256  + 64 * (j))
#define XB_XSUB(j)  (1280 + 64 * (j))
#define XB_XGEN(j)  (2304 + 64 * (j))
#define XB_TOP      3328
#define XB_TOPGEN   3392
#define XCD_BAR_WORDS 3456
#define XB_SPIN_CAP (1u << 18)

__device__ __forceinline__ unsigned xb_ld(unsigned* p)              { return __hip_atomic_load(p, __ATOMIC_RELAXED, __HIP_MEMORY_SCOPE_AGENT); }
__device__ __forceinline__ unsigned xb_add(unsigned* p, unsigned v) { return __hip_atomic_fetch_add(p, v, __ATOMIC_RELAXED, __HIP_MEMORY_SCOPE_AGENT); }
__device__ __forceinline__ unsigned xb_xcc_id() { return (unsigned)__builtin_amdgcn_s_getreg((3 << 11) | 20) & 0xFu; }
#define XB_SPIN(cond, bar) do { unsigned _sp = 0; while (cond) { __builtin_amdgcn_s_sleep(1); \
    if ((++_sp & 255u) == 0u) { if (xb_ld(&(bar)[XB_TMO])) break; if (_sp > XB_SPIN_CAP) { atomicAdd(&(bar)[XB_TMO], 1u); break; } } } } while (0)

struct XcdBarrier {
    unsigned* bar; unsigned x;
    volatile LAS unsigned* st;
};

__device__ __forceinline__ XcdBarrier xcd_barrier_post(unsigned* bar, volatile LAS unsigned* st) {
    XcdBarrier b; b.bar = bar; b.x = xb_xcc_id(); b.st = st;
    if (threadIdx.x == 0) (void)xb_add(&bar[XB_XCNT(b.x)], 1u);
    return b;
}
__device__ __forceinline__ void xcd_barrier_complete(unsigned* bar, unsigned x, unsigned& nloc, unsigned& nx) {
    const unsigned G = gridDim.x * gridDim.y * gridDim.z;
    unsigned sum, cnt, mine, sp = 0u;
    for (;;) {
        sum = 0u; cnt = 0u; mine = 0u;
#pragma unroll
        for (unsigned j = 0; j < 16; ++j) { const unsigned c = xb_ld(&bar[XB_XCNT(j)]); sum += c; cnt += (c > 0u) ? 1u : 0u; mine = (j == x) ? c : mine; }
        if (sum == G) break;
        __builtin_amdgcn_s_sleep(1);
        if ((++sp & 255u) == 0u) { if (xb_ld(&bar[XB_TMO])) break; if (sp > XB_SPIN_CAP) { atomicAdd(&bar[XB_TMO], 1u); break; } }
    }
    nloc = mine > 0u ? mine : 1u; nx = cnt > 0u ? cnt : 1u;
}

__device__ __forceinline__ void xcd_barrier(const XcdBarrier& b) {
    asm volatile("s_waitcnt vmcnt(0)" ::: "memory");
    __syncthreads();
    if (threadIdx.x == 0) {
        unsigned* bar = b.bar;
        __builtin_amdgcn_s_waitcnt(0);
        unsigned nloc = b.st[0], nx = b.st[1];
        if (nloc == 0u) { xcd_barrier_complete(bar, b.x, nloc, nx); b.st[0] = nloc; b.st[1] = nx; }
        const unsigned old = xb_add(&bar[XB_XSUB(b.x)], 1u);
        const unsigned gen = old / nloc;
        if (old + 1u == (gen + 1u) * nloc) {
            __builtin_amdgcn_fence(__ATOMIC_RELEASE, "agent");
            asm volatile("s_waitcnt vmcnt(0)" ::: "memory");
            const unsigned og = xb_add(&bar[XB_TOP], 1u);
            const unsigned tg = og / nx;
            if (og + 1u == (tg + 1u) * nx) xb_add(&bar[XB_TOPGEN], 1u);
            else XB_SPIN(xb_ld(&bar[XB_TOPGEN]) == tg, bar);
            __builtin_amdgcn_fence(__ATOMIC_ACQUIRE, "agent");
            xb_add(&bar[XB_XGEN(b.x)], 1u);
            asm volatile("s_waitcnt vmcnt(0)" ::: "memory");
        } else {
            XB_SPIN(xb_ld(&bar[XB_XGEN(b.x)]) == gen, bar);
            __builtin_amdgcn_fence(__ATOMIC_ACQUIRE, "agent");
            asm volatile("s_waitcnt vmcnt(0)" ::: "memory");
        }
    }
    __syncthreads();
}

struct Args {
    const float* x_prompt; const float* x_sample; const float* norm_g; const float* w_in; const float* w_oa; const float* w_ob; const float* w_oc; const float* w_out;
    const float* b_sink; const float* lam_q1; const float* lam_k1; const float* lam_q2; const float* lam_k2; const float* c_subln_g; const float* final_norm_g;
    float* out; unsigned char* ws;
};

typedef const __attribute__((address_space(4))) Args* KArgs;
__device__ __forceinline__ KArgs kargs() { auto p = __builtin_amdgcn_kernarg_segment_ptr(); asm volatile("" : "+s"(p)); return (KArgs)p; }

__global__ void __launch_bounds__(512, 2) fwd_kernel(Args a_unused) {
    extern __shared__ __attribute__((aligned(16))) unsigned char lds_raw[];
    LAS unsigned char* lds = (LAS unsigned char*)lds_raw;
#define OPAQUE_IDS() int tid = threadIdx.x; asm volatile("" : "+v"(tid)); const int lane = tid & 63, wave = __builtin_amdgcn_readfirstlane(tid >> 6); (void)lane; (void)wave
#define GW_ ((int)blockIdx.x * 8 + wave)
#define NGW_ ((int)gridDim.x * 8)
    if (threadIdx.x < 32) ((LAS unsigned*)(lds + MISC_BASE))[threadIdx.x] = 0u, ((LAS unsigned*)(lds + MISC_BASE))[threadIdx.x + 32] = 0u, ((LAS unsigned*)(lds + MISC_BASE))[threadIdx.x + 64] = 0u, ((LAS unsigned*)(lds + MISC_BASE))[threadIdx.x + 96] = 0u;
    __syncthreads();
    { KArgs A_ = kargs(); (void)xcd_barrier_post((unsigned*)(A_->ws + WS_BAR), (volatile LAS unsigned*)(lds + MISC_OFF)); }
#define GRID_BAR() do { KArgs A_ = kargs(); XcdBarrier b_; b_.bar = (unsigned*)(A_->ws + WS_BAR); b_.x = xb_xcc_id(); b_.st = (volatile LAS unsigned*)(lds + MISC_OFF); xcd_barrier(b_); } while (0)

    {
        OPAQUE_IDS();
        KArgs A = kargs(); unsigned char* ws = A->ws;
        bf16_t* WIN = (bf16_t*)(ws + WS_WIN); bf16_t* WO3 = (bf16_t*)(ws + WS_WO3); bf16_t* WOUT = (bf16_t*)(ws + WS_WOUT); bf16_t* XB = (bf16_t*)(ws + WS_XB); float* rowss = (float*)(ws + WS_ROWSS);
        LAS float* scr = (LAS float*)(lds + wave * 16384);
        constexpr int I_IN = 16 * 360, I_O = 8 * 32, I_OUT = 16 * 32, I_L = I_IN + 3 * I_O + I_OUT;
        for (int it = GW_; it < DEPTH * I_L; it += NGW_) {
            const int l = it / I_L; int r = it - l * I_L;
            if (r < I_IN) { transpose_item(A->w_in + (size_t)l * 1024 * 11520, 1024, 11520, WIN + (size_t)l * 11520 * 1024, A->norm_g + l * 1024, scr, r, lane); continue; } r -= I_IN;
            if (r < I_O) { transpose_item(A->w_oa + (size_t)l * 512 * 1024, 512, 1024, WO3 + (size_t)(l * 3 + 0) * 1024 * 512, nullptr, scr, r, lane); continue; } r -= I_O;
            if (r < I_O) { transpose_item(A->w_ob + (size_t)l * 512 * 1024, 512, 1024, WO3 + (size_t)(l * 3 + 1) * 1024 * 512, nullptr, scr, r, lane); continue; } r -= I_O;
            if (r < I_O) { transpose_item(A->w_oc + (size_t)l * 512 * 1024, 512, 1024, WO3 + (size_t)(l * 3 + 2) * 1024 * 512, nullptr, scr, r, lane); continue; } r -= I_O;
            transpose_item(A->w_out + (size_t)l * 1024 * 1024, 1024, 1024, WOUT + (size_t)l * 1024 * 1024, nullptr, scr, r, lane);
        }
        for (int row = GW_; row < NTOK; row += NGW_) {
            const float* src = (row < 16384) ? A->x_prompt + (size_t)row * 1024 : A->x_sample + (size_t)(row - 16384) * 1024;
            row_to_bf16(src, XB + (size_t)row * 1024, rowss + row, lane);
        }
    }
    cg::this_grid().sync();

#pragma unroll 1
    for (int c = 0; c < NCHUNK; ++c) {
#pragma unroll 1
        for (int l = 0; l < DEPTH; ++l) {
            {
                OPAQUE_IDS();
                KArgs A = kargs(); unsigned char* ws = A->ws; float* rowss = (float*)(ws + WS_ROWSS);
                const size_t crow0 = (size_t)c * MC; const int G = gridDim.x, bid = blockIdx.x;
                if (l == 0 && c > 0) { for (int row = GW_; row < MC; row += NGW_) { const size_t rr = crow0 - MC + row; final_norm_row(A->out + rr * 1024, rowss + rr, A->final_norm_g, lane); } }
                { float* rz = rowss + (size_t)((l + 1) & 1) * NTOK + crow0; for (int i = bid * 512 + tid; i < MC; i += G * 512) rz[i] = 0.f; }
#ifndef SKIP_P1
                pg8::Gemm g{(bf16_t*)(ws + WS_XB) + crow0 * 1024, (bf16_t*)(ws + WS_WIN) + (size_t)l * 11520 * 1024, MC, DIN, 1024, 0, 0};
                pg8::OrderXcd So; So.init(MC, DIN - 256, G, bid);
                pg8::EpiProj E{(bf16_t*)(ws + WS_P), rowss + (size_t)(l & 1) * NTOK + crow0};
                pg8::gemm_phase<pg8::EpiProj, pg8::OrderXcd, true, true>(lds, g, So, E);
#endif
            }
            GRID_BAR();
            {
                const int S = (c == 0) ? 8192 : 2048;
                const int G = gridDim.x, bid = blockIdx.x;
#ifndef SKIP_C
                {
                    OPAQUE_IDS();
                    KArgs A = kargs(); unsigned char* ws = A->ws;
                    const float lam_init = 0.8f - 0.6f * expf(-0.3f * (float)l);
                    float d1 = A->lam_q1[l * 64 + lane] * A->lam_k1[l * 64 + lane], d2 = A->lam_q2[l * 64 + lane] * A->lam_k2[l * 64 + lane];
                    d1 = wave_sum(d1); d2 = wave_sum(d2);
                    const float lam = expf(d1) - expf(d2) + lam_init;
                    const bf16_t* P = (const bf16_t*)(ws + WS_P); bf16_t* act_c = (bf16_t*)(ws + WS_ACT) + (size_t)2 * MC * 512;
                    const float* sg = A->c_subln_g + l * 128;
                    for (int it = bid; it < 512; it += G) {
                        const int x = it & 7, y = it >> 3; int pair, qb;
                        if (c == 0) { pair = x; qb = y; } else { pair = x + 8 * (y >> 4); qb = y & 15; }
                        const int seq = pair >> 2, h = (it & 256) ? 3 - (pair & 3) : (pair & 3);
                        attn_C_item(P, act_c, S, seq * S, qb * 128, h, lam, 1.0f - lam_init, sg, (LAS char*)lds, tid, wave, lane);
                    }
                }
#endif
#ifndef SKIP_P1
                {
                    OPAQUE_IDS();
                    KArgs A = kargs(); unsigned char* ws = A->ws; float* rowss = (float*)(ws + WS_ROWSS);
                    const size_t crow0 = (size_t)c * MC;
                    pg8::Gemm g{(bf16_t*)(ws + WS_XB) + crow0 * 1024, (bf16_t*)(ws + WS_WIN) + (size_t)l * 11520 * 1024, MC, DIN, 1024, 0, 0};
                    pg8::OrderFixed So{((bid >> 3) << 1) + ((bid >> 2) & 1), 44, (bid & 3) == 0 && bid < 256};
                    pg8::EpiProj E{(bf16_t*)(ws + WS_P), rowss + (size_t)(l & 1) * NTOK + crow0};
                    __syncthreads();
                    pg8::gemm_phase<pg8::EpiProj, pg8::OrderFixed, true, true>(lds, g, So, E);
                    __syncthreads();
                }
#endif
#ifndef SKIP_A
                {
                    OPAQUE_IDS();
                    KArgs A = kargs(); unsigned char* ws = A->ws;
                    const bf16_t* P = (const bf16_t*)(ws + WS_P); bf16_t* act_a = (bf16_t*)(ws + WS_ACT);
                    unsigned* ctr = (unsigned*)(ws + WS_BAR + 14400) + (c * 4 + l) * 16;
                    volatile LAS unsigned* slot = (volatile LAS unsigned*)(lds + MISC_BASE + 128);
                    for (;;) {
                        __syncthreads();
                        if (tid == 0) *slot = atomicAdd(ctr, 1u);
                        __syncthreads();
                        const int idx = (int)*slot;
                        if (idx >= 256) break;
                        const int span = idx >> 3, h = idx & 7;
                        const int tokb = span * 512, seq = tokb / S, tl = tokb - seq * S;
                        attn_A_span(P, act_a, S, seq * S, tl, h, (LAS char*)lds, wave, lane);
                    }
                }
#endif
#ifndef SKIP_B
                {
                    OPAQUE_IDS(); LAS char* vl = (LAS char*)lds + wave * WV_LDS;
                    KArgs A = kargs(); unsigned char* ws = A->ws;
                    const bf16_t* P = (const bf16_t*)(ws + WS_P); bf16_t* act_b = (bf16_t*)(ws + WS_ACT) + (size_t)MC * 512;
                    unsigned* ctr = (unsigned*)(ws + WS_BAR + 14400) + (c * 4 + l) * 16 + 8;
                    volatile LAS unsigned* slot = (volatile LAS unsigned*)(lds + MISC_BASE + 128);
                    for (;;) {
                        __syncthreads();
                        if (tid == 0) *slot = atomicAdd(ctr, 1u);
                        __syncthreads();
                        const int br = (int)*slot;
                        if (br >= 512) break;
                        const int span = br >> 1, hq = 4 * (br & 1) + (wave & 3);
                        const int tokb = span * 64, seq = tokb / S, tl = tokb - seq * S;
                        attn_B_wave(P, act_b, S, seq * S, tl + 32 * (wave >> 2), hq, A->b_sink[l * 8 + hq], vl, lane);
                    }
                }
#endif
            }
            GRID_BAR();
            {
#ifndef SKIP_P3
                KArgs A = kargs(); unsigned char* ws = A->ws;
                pg8::Gemm g{(bf16_t*)(ws + WS_ACT), (bf16_t*)(ws + WS_WO3) + (size_t)l * 3 * 1024 * 512, MC, 1024, 512, (size_t)MC * 512 * 2, (size_t)1024 * 512 * 2};
                pg8::OrderMix So{4, (MC / 256) * 4, (int)gridDim.x, (int)blockIdx.x};
                pg8::EpiMix E{(const bf16_t*)(ws + WS_P), (bf16_t*)(ws + WS_MIX)};
                pg8::gemm_phase<pg8::EpiMix, pg8::OrderMix, true, true>(lds, g, So, E);
#endif
            }
            GRID_BAR();
            {
#ifndef SKIP_P4
                KArgs A = kargs(); unsigned char* ws = A->ws;
                const size_t crow0 = (size_t)c * MC;
                pg8::Gemm g{(bf16_t*)(ws + WS_MIX), (bf16_t*)(ws + WS_WOUT) + (size_t)l * 1024 * 1024, MC, 1024, 1024, 0, 0};
                pg8::OrderOne So{4, (MC / 256) * 4, (int)gridDim.x, (int)blockIdx.x};
                const float* base = (l == 0) ? ((c == 0) ? A->x_prompt : A->x_sample + (size_t)(c - 1) * MC * 1024) : A->out + crow0 * 1024;
                pg8::EpiOut E{base, A->out + crow0 * 1024, (bf16_t*)(ws + WS_XB) + crow0 * 1024, (float*)(ws + WS_ROWSS) + (size_t)((l + 1) & 1) * NTOK + crow0};
                pg8::gemm_phase<pg8::EpiOut, pg8::OrderOne, true, true>(lds, g, So, E);
#endif
            }
            GRID_BAR();
        }
    }
    {
        OPAQUE_IDS();
        KArgs A = kargs(); float* rowss = (float*)(A->ws + WS_ROWSS);
        for (int row = GW_; row < MC; row += NGW_) { const size_t rr = (size_t)(NCHUNK - 1) * MC + row; final_norm_row(A->out + rr * 1024, rowss + rr, A->final_norm_g, lane); }
    }
}

extern "C" void kernel_launch(void* const* d_in, const int* in_sizes, int n_in, void* d_out, int out_size, void* d_ws, size_t ws_size, hipStream_t stream) {
    static int grid = 0;
    if (grid == 0) {
        if (n_in != 15 || out_size != NTOK * DM || ws_size < WS_END) { fprintf(stderr, "kernel_launch: unexpected shapes (n_in %d, out %d, ws %zu)\n", n_in, out_size, ws_size); grid = -1; return; }
        int dev = 0, cus = 0, per_cu = 0;
        if (hipGetDevice(&dev) != hipSuccess || hipDeviceGetAttribute(&cus, hipDeviceAttributeMultiprocessorCount, dev) != hipSuccess) { grid = -1; return; }
        if (hipFuncSetAttribute((const void*)fwd_kernel, hipFuncAttributeMaxDynamicSharedMemorySize, LDS_BYTES) != hipSuccess) { grid = -1; return; }
        if (hipOccupancyMaxActiveBlocksPerMultiprocessor(&per_cu, (const void*)fwd_kernel, 512, LDS_BYTES) != hipSuccess || per_cu < 1) per_cu = 1;
        (void)hipGetLastError();
        grid = cus * per_cu;
        if (grid != 256) { fprintf(stderr, "kernel_launch: this kernel's work split is built for a 256-workgroup grid (256 CUs x 1); got %d; nothing launched\n", grid); grid = -1; return; }
    }
    if (grid < 0) return;
    Args a{};
    a.x_prompt = (const float*)d_in[0]; a.x_sample = (const float*)d_in[1]; a.norm_g = (const float*)d_in[2]; a.w_in = (const float*)d_in[3];
    a.w_oa = (const float*)d_in[4]; a.w_ob = (const float*)d_in[5]; a.w_oc = (const float*)d_in[6]; a.w_out = (const float*)d_in[7];
    a.b_sink = (const float*)d_in[8]; a.lam_q1 = (const float*)d_in[9]; a.lam_k1 = (const float*)d_in[10]; a.lam_q2 = (const float*)d_in[11]; a.lam_k2 = (const float*)d_in[12];
    a.c_subln_g = (const float*)d_in[13]; a.final_norm_g = (const float*)d_in[14];
    a.out = (float*)d_out; a.ws = (unsigned char*)d_ws;
    if (hipMemsetAsync((char*)d_ws + WS_BAR, 0, 16384, stream) != hipSuccess) { fprintf(stderr, "memset failed\n"); return; }
    void* args[] = {&a};
    hipError_t e = hipLaunchCooperativeKernel((void*)fwd_kernel, dim3(grid), dim3(512), args, LDS_BYTES, stream);
    if (e != hipSuccess) fprintf(stderr, "cooperative launch failed: %s (grid %d)\n", hipGetErrorString(e), grid);
}
```
